# Optimizing an MI355X kernel written in HIP

```python
import math
import jax, jax.numpy as jnp
from jax import lax
import numpy as np

D_MODEL = 2048
BATCH = 4
SEQ = 2048
DEPTH = 1

N_META = 16
ATTN_WIDTH = D_MODEL // 2
POOL_WIDTH = D_MODEL - ATTN_WIDTH
N_HEADS = 8
HEAD_DIM = ATTN_WIDTH // N_HEADS
KV_RANK = D_MODEL // 8
IDX_HEADS = 16
IDX_DIM = 64
TOPK_MAX = 256
POOL_WINDOWS = (2, 4, 8, 16)
POOL_GROUP = POOL_WIDTH // len(POOL_WINDOWS)
D_FF = ((8 * D_MODEL // 3 + 255) // 256) * 256
CONV_WIDTH = 3
REL_BUCKETS = 32
REL_MAX_DIST = 128
Q_BLOCK = 128
ALPHA = (2.0 * DEPTH) ** 0.25
BETA = (8.0 * DEPTH) ** -0.25
LN_EPS = 1e-5
NEG_INF = -1e30
PROJ_SIZES = (ATTN_WIDTH, KV_RANK, IDX_HEADS * IDX_DIM, IDX_DIM, IDX_HEADS, POOL_WIDTH)
PROJ_COLS = sum(PROJ_SIZES)

kernel_name = "hybrid_dsa_pool_deepnorm_layer"


def layer_norm(x, g, b):
    xf = x.astype(jnp.float32)
    mu = jnp.mean(xf, axis=-1, keepdims=True)
    var = jnp.mean(jnp.square(xf - mu), axis=-1, keepdims=True)
    return ((xf - mu) * lax.rsqrt(var + LN_EPS) * g.astype(jnp.float32) + b.astype(jnp.float32)).astype(x.dtype)


def rms_norm(x, g):
    xf = x.astype(jnp.float32)
    return (xf * lax.rsqrt(jnp.mean(jnp.square(xf), axis=-1, keepdims=True) + LN_EPS) * g.astype(jnp.float32)).astype(x.dtype)


def split_columns(p):
    offs = np.cumsum(PROJ_SIZES)[:-1].tolist()
    return jnp.split(p, offs, axis=-1)


def t5_bucket(dist):
    max_exact = REL_BUCKETS // 2
    d_f = jnp.maximum(dist, 1).astype(jnp.float32)
    large = max_exact + (jnp.log(d_f / max_exact) / math.log(REL_MAX_DIST / max_exact)
                         * (REL_BUCKETS - max_exact)).astype(jnp.int32)
    large = jnp.minimum(large, REL_BUCKETS - 1)
    return jnp.where(dist < max_exact, dist, large)


def dsa_attention(q_abs, c_kv, q_idx, k_idx, w_idx, rel_bias, top_k):
    B, T = c_kv.shape[0], c_kv.shape[1]
    n_blocks = -(-T // Q_BLOCK)
    t_pad = n_blocks * Q_BLOCK - T

    def to_blocks(a):
        a = jnp.pad(a, [(0, 0), (0, t_pad)] + [(0, 0)] * (a.ndim - 2))
        return jnp.moveaxis(a.reshape((B, n_blocks, Q_BLOCK) + a.shape[2:]), 1, 0)

    key_pos = jnp.arange(T, dtype=jnp.int32)

    def block(args):
        qa, qi, wi, blk = args
        t = blk * Q_BLOCK + jnp.arange(Q_BLOCK, dtype=jnp.int32)
        dots = jnp.einsum('bqhd,bsd->bqhs', qi, k_idx)
        score = jnp.einsum('bqhs,bqh->bqs', jax.nn.relu(dots), wi).astype(jnp.float32)
        causal = key_pos[None, :] <= t[:, None]
        score = jnp.where(causal[None], score, NEG_INF)
        _, sel = lax.top_k(score, top_k)
        c_sel = jax.vmap(lambda c, i: c[i])(c_kv, sel)
        logits = jnp.einsum('bqhc,bqkc->bhqk', qa, c_sel).astype(jnp.float32) * (HEAD_DIM ** -0.5)
        dist = t[None, :, None] - sel
        bias = rel_bias[t5_bucket(jnp.maximum(dist, 0))].astype(jnp.float32)
        logits = logits + jnp.moveaxis(bias, -1, 1)
        logits = jnp.where((dist >= 0)[:, None], logits, NEG_INF)
        p = jax.nn.softmax(logits, axis=-1).astype(c_sel.dtype)
        return jnp.einsum('bhqk,bqkc->bqhc', p, c_sel)

    out = lax.map(block, (to_blocks(q_abs), to_blocks(q_idx), to_blocks(w_idx),
                          jnp.arange(n_blocks, dtype=jnp.int32)))
    out = jnp.moveaxis(out, 0, 1).reshape((B, n_blocks * Q_BLOCK) + out.shape[3:])
    return out[:, :T]


def multiscale_pool(u, w_pool, scale):
    B, T, C = u.shape
    cs = jnp.cumsum(u.astype(jnp.float32), axis=1)
    cp = jnp.concatenate([jnp.zeros((B, 1, C), jnp.float32), cs], axis=1)
    pos = jnp.arange(T, dtype=jnp.int32)
    outs = []
    for g, w in enumerate(POOL_WINDOWS):
        lo = g * POOL_GROUP
        cg = cp[..., lo:lo + POOL_GROUP]
        start = jnp.maximum(pos + 1 - w, 0)
        win_sum = cg[:, 1:] - jnp.take(cg, start, axis=1)
        count = jnp.minimum(pos + 1, w).astype(jnp.float32)[None, :, None]
        diff = (win_sum / count).astype(u.dtype) - u[..., lo:lo + POOL_GROUP]
        outs.append(diff @ w_pool[g])
    return jnp.concatenate(outs, axis=-1) * scale


def conv_gated_ffn(h, w_up, conv_w, conv_b, w_down):
    T = h.shape[1]
    z = h @ w_up
    zp = jnp.pad(z, ((0, 0), (CONV_WIDTH - 1, 0), (0, 0)))
    z = sum(zp[:, j:j + T] * conv_w[j] for j in range(CONV_WIDTH)) + conv_b
    a, g = jnp.split(z, 2, axis=-1)
    return (jax.nn.gelu(a) * g) @ w_down


def setup_inputs(seed: int = 0) -> dict:
    key = jax.random.key(seed)
    ks = jax.random.split(key, 20)
    f32 = jnp.float32
    nrm = lambda k, s, sc: jax.random.normal(k, s, f32) * sc
    L = DEPTH
    return {
        "x": nrm(ks[0], (BATCH, SEQ, D_MODEL), 1.0),
        "meta": nrm(ks[1], (N_META, D_MODEL), 1.0),
        "rel_bias": nrm(ks[2], (REL_BUCKETS, N_HEADS), 0.5),
        "w_in": nrm(ks[3], (L, D_MODEL, PROJ_COLS), D_MODEL ** -0.5),
        "kv_norm_g": 1.0 + nrm(ks[4], (L, KV_RANK), 0.02),
        "w_uk": nrm(ks[5], (L, KV_RANK, N_HEADS, HEAD_DIM), KV_RANK ** -0.5),
        "w_uv": nrm(ks[6], (L, KV_RANK, N_HEADS, HEAD_DIM), BETA * KV_RANK ** -0.5),
        "w_pool": nrm(ks[7], (L, len(POOL_WINDOWS), POOL_GROUP, POOL_GROUP), BETA * POOL_GROUP ** -0.5),
        "pool_scale": 1.0 + nrm(ks[8], (L, POOL_WIDTH), 0.02),
        "w_o": nrm(ks[9], (L, D_MODEL, D_MODEL), BETA * D_MODEL ** -0.5),
        "ln1_g": 1.0 + nrm(ks[10], (L, D_MODEL), 0.02),
        "ln1_b": nrm(ks[11], (L, D_MODEL), 0.02),
        "w_up": nrm(ks[12], (L, D_MODEL, 2 * D_FF), D_MODEL ** -0.5),
        "conv_w": nrm(ks[13], (L, CONV_WIDTH, 2 * D_FF), CONV_WIDTH ** -0.5),
        "conv_b": nrm(ks[14], (L, 2 * D_FF), 0.02),
        "w_down": nrm(ks[15], (L, D_FF, D_MODEL), BETA * D_FF ** -0.5),
        "ln2_g": 1.0 + nrm(ks[16], (L, D_MODEL), 0.02),
        "ln2_b": nrm(ks[17], (L, D_MODEL), 0.02),
    }


def reference(x, meta, rel_bias, w_in, kv_norm_g, w_uk, w_uv, w_pool, pool_scale, w_o,
              ln1_g, ln1_b, w_up, conv_w, conv_b, w_down, ln2_g, ln2_b):
    B, S, D = x.shape
    top_k = min(TOPK_MAX, S // 4)
    h = jnp.concatenate([jnp.broadcast_to(meta[None].astype(x.dtype), (B, N_META, D)), x], axis=1)
    T = h.shape[1]
    for l in range(DEPTH):
        q, c_kv, q_idx, k_idx, w_idx, u = split_columns(h @ w_in[l])
        q = q.reshape(B, T, N_HEADS, HEAD_DIM)
        c_kv = rms_norm(c_kv, kv_norm_g[l])
        q_abs = jnp.einsum('bthd,chd->bthc', q, w_uk[l])
        q_idx = q_idx.reshape(B, T, IDX_HEADS, IDX_DIM) * (IDX_DIM ** -0.5)
        w_idx = w_idx * (IDX_HEADS ** -0.5)
        o_lat = dsa_attention(q_abs, c_kv, q_idx, k_idx, w_idx, rel_bias, top_k)
        attn_out = jnp.einsum('bthc,chd->bthd', o_lat, w_uv[l]).reshape(B, T, ATTN_WIDTH)
        pool_out = multiscale_pool(u, w_pool[l], pool_scale[l])
        mix = jnp.concatenate([attn_out, pool_out], axis=-1) @ w_o[l]
        h = layer_norm(ALPHA * h + mix, ln1_g[l], ln1_b[l])
        f = conv_gated_ffn(h, w_up[l], conv_w[l], conv_b[l], w_down[l])
        h = layer_norm(ALPHA * h + f, ln2_g[l], ln2_b[l])
    return h[:, N_META:]
```

```cpp
#include <hip/hip_runtime.h>
#include <cstdint>
#include <cstdio>

typedef unsigned short bf16_t;
typedef short bf16x8 __attribute__((ext_vector_type(8)));
typedef float f32x4 __attribute__((ext_vector_type(4)));
typedef unsigned u32x4 __attribute__((ext_vector_type(4)));

constexpr int D_MODEL = 2048, BATCH = 4, SEQ = 2048, N_META = 16, T = SEQ + N_META;
constexpr int NH = 8, HD = 128, CKV = 256, IH = 16, IDIM = 64, TOPK = 256;
constexpr int POOLW = 1024, PG = 256, D_FF = 5632;
constexpr int PROJ = 3408, PROJ_PAD = 3584;
constexpr int C_Q = 0, C_CKV = 1024, C_QI = 1280, C_KI = 2304, C_WI = 2368, C_U = 2384;
constexpr int R = BATCH * SEQ + N_META;
constexpr int RREAL = BATCH * SEQ;
constexpr float ALPHA = 1.189207115002721f;
constexpr float LN_EPS = 1e-5f;
constexpr int MW = 68;
constexpr int SCP = 2080;

__host__ __device__ __forceinline__ int rid(int b, int t) { return t < N_META ? RREAL + t : b * SEQ + (t - N_META); }

__device__ __forceinline__ unsigned f2bf(float f) { unsigned u = __builtin_bit_cast(unsigned, f); return (u + 0x7fffu + ((u >> 16) & 1u)) >> 16; }
__device__ __forceinline__ float bf2f(bf16_t h) { return __builtin_bit_cast(float, (unsigned)h << 16); }

__device__ const unsigned char T5_BUCKET[128] = {
    0, 1, 2, 3, 4, 5, 6, 7, 8, 9, 10, 11, 12, 13, 14, 15, 16, 16, 16, 17, 17, 18, 18, 18, 19, 19, 19, 20, 20, 20, 20, 21, 21, 21, 21, 22, 22, 22, 22, 22,
    23, 23, 23, 23, 23, 23, 24, 24, 24, 24, 24, 24, 25, 25, 25, 25, 25, 25, 25, 26, 26, 26, 26, 26, 26, 26, 26, 27, 27, 27, 27, 27, 27, 27, 27, 27, 27,
    28, 28, 28, 28, 28, 28, 28, 28, 28, 28, 29, 29, 29, 29, 29, 29, 29, 29, 29, 29, 29, 29, 30, 30, 30, 30, 30, 30, 30, 30, 30, 30, 30, 30, 30, 30,
    31, 31, 31, 31, 31, 31, 31, 31, 31, 31, 31, 31, 31, 31, 31};

__global__ void k_rows_bf16(const float* __restrict__ x, const float* __restrict__ meta, bf16_t* __restrict__ hb) {
    const size_t n4 = (size_t)R * D_MODEL / 4;
    for (size_t i = (size_t)blockIdx.x * blockDim.x + threadIdx.x; i < n4; i += (size_t)gridDim.x * blockDim.x) {
        const size_t e = i * 4; const int row = (int)(e / D_MODEL), col = (int)(e % D_MODEL);
        const float* src = row < RREAL ? x + (size_t)row * D_MODEL + col : meta + (size_t)(row - RREAL) * D_MODEL + col;
        const float4 v = *(const float4*)src;
        uint2 o; o.x = f2bf(v.x) | (f2bf(v.y) << 16); o.y = f2bf(v.z) | (f2bf(v.w) << 16);
        *(uint2*)(hb + e) = o;
    }
}
__global__ void k_transpose(const float* __restrict__ W, bf16_t* __restrict__ WT, int K, int N, int NP) {
    __shared__ float tile[32][33];
    const int n0 = blockIdx.x * 32, k0 = blockIdx.y * 32, tx = threadIdx.x & 31, ty = threadIdx.x >> 5;
    for (int i = ty; i < 32; i += 8) { const int k = k0 + i, n = n0 + tx; tile[i][tx] = (k < K && n < N) ? W[(size_t)k * N + n] : 0.f; }
    __syncthreads();
    for (int i = ty; i < 32; i += 8) { const int n = n0 + i, k = k0 + tx; if (n < NP && k < K) WT[(size_t)n * K + k] = (bf16_t)f2bf(tile[tx][i]); }
}
__global__ void k_cvt(const float* __restrict__ s, bf16_t* __restrict__ d, size_t n) {
    for (size_t i = (size_t)blockIdx.x * blockDim.x + threadIdx.x; i < n; i += (size_t)gridDim.x * blockDim.x) d[i] = (bf16_t)f2bf(s[i]);
}

struct GemmP { const bf16_t* A; const bf16_t* Bt; size_t zA, zB; int M, N, K, lda, ldb, pad; };
template <class Epi>
__global__ __launch_bounds__(256) void k_gemm(GemmP g, Epi epi) {
    __shared__ __attribute__((aligned(16))) bf16_t sA[128 * 40];
    __shared__ __attribute__((aligned(16))) bf16_t sB[128 * 40];
    const int tid = threadIdx.x, lane = tid & 63, wid = tid >> 6, wr = wid >> 1, wc = wid & 1, fr = lane & 15, fq = lane >> 4;
    const int z = blockIdx.z; const bf16_t* A = g.A + (size_t)z * g.zA; const bf16_t* Bt = g.Bt + (size_t)z * g.zB;
    const int m0 = blockIdx.y * 128, n0 = blockIdx.x * 128;
    f32x4 acc[4][4];
#pragma unroll
    for (int i = 0; i < 4; ++i)
#pragma unroll
        for (int j = 0; j < 4; ++j) acc[i][j] = (f32x4){0.f, 0.f, 0.f, 0.f};
    for (int k0 = 0; k0 < g.K; k0 += 32) {
#pragma unroll
        for (int i = 0; i < 2; ++i) {
            const int ch = tid + i * 256, r = ch >> 2, c = (ch & 3) * 8;
            int ra = m0 + r; if (ra >= g.M) ra = g.M - 1;
            int rb = n0 + r; if (rb >= g.N) rb = g.N - 1;
            *(u32x4*)(sA + r * 40 + c) = *(const u32x4*)(A + (size_t)ra * g.lda + k0 + c);
            *(u32x4*)(sB + r * 40 + c) = *(const u32x4*)(Bt + (size_t)rb * g.ldb + k0 + c);
        }
        __syncthreads();
        bf16x8 af[4], bfr[4];
#pragma unroll
        for (int i = 0; i < 4; ++i) af[i] = *(const bf16x8*)(sA + (wr * 64 + i * 16 + fr) * 40 + fq * 8);
#pragma unroll
        for (int j = 0; j < 4; ++j) bfr[j] = *(const bf16x8*)(sB + (wc * 64 + j * 16 + fr) * 40 + fq * 8);
#pragma unroll
        for (int i = 0; i < 4; ++i)
#pragma unroll
            for (int j = 0; j < 4; ++j) acc[i][j] = __builtin_amdgcn_mfma_f32_16x16x32_bf16(af[i], bfr[j], acc[i][j], 0, 0, 0);
        __syncthreads();
    }
#pragma unroll
    for (int i = 0; i < 4; ++i)
#pragma unroll
        for (int j = 0; j < 4; ++j)
#pragma unroll
            for (int e = 0; e < 4; ++e) {
                const int row = m0 + wr * 64 + i * 16 + fq * 4 + e, col = n0 + wc * 64 + j * 16 + fr;
                if (row < g.M && col < g.N) epi(row, col, acc[i][j][e], z);
            }
}
struct EpiProj {
    bf16_t* q; float* ckvraw; bf16_t* qidx; bf16_t* kidx; float* widx; float* u;
    __device__ __forceinline__ void operator()(int row, int col, float v, int) const {
        if (col < C_CKV) q[(size_t)row * 1024 + col] = (bf16_t)f2bf(v);
        else if (col < C_QI) ckvraw[(size_t)row * CKV + (col - C_CKV)] = v;
        else if (col < C_KI) qidx[(size_t)row * 1024 + (col - C_QI)] = (bf16_t)f2bf(v * 0.125f);
        else if (col < C_WI) kidx[(size_t)row * IDIM + (col - C_KI)] = (bf16_t)f2bf(v);
        else if (col < C_U) widx[(size_t)row * IH + (col - C_WI)] = v * 0.25f;
        else if (col < PROJ) u[(size_t)row * POOLW + (col - C_U)] = v;
    }
};
struct EpiBf16Z { bf16_t* C; const float* scale; size_t zC; int ldc; int zscale;
    __device__ __forceinline__ void operator()(int row, int col, float v, int z) const {
        if (scale) v *= scale[z * zscale + col];
        C[(size_t)z * zC + (size_t)row * ldc + col] = (bf16_t)f2bf(v); } };
struct EpiF32 { float* C; int ldc; int pad;
    __device__ __forceinline__ void operator()(int row, int col, float v, int) const { C[(size_t)row * ldc + col] = v; } };

__global__ void k_rmsnorm(const float* __restrict__ raw, const float* __restrict__ g, bf16_t* __restrict__ ckv) {
    const int row = blockIdx.x * 4 + (threadIdx.x >> 6), lane = threadIdx.x & 63; if (row >= R) return;
    const float4 v = *(const float4*)(raw + (size_t)row * CKV + lane * 4);
    float s = v.x * v.x + v.y * v.y + v.z * v.z + v.w * v.w;
#pragma unroll
    for (int o = 1; o < 64; o <<= 1) s += __shfl_xor(s, o);
    const float r = 1.0f / sqrtf(s * (1.0f / CKV) + LN_EPS);
    const float4 gg = *(const float4*)(g + lane * 4);
    uint2 o; o.x = f2bf(v.x * r * gg.x) | (f2bf(v.y * r * gg.y) << 16); o.y = f2bf(v.z * r * gg.z) | (f2bf(v.w * r * gg.w) << 16);
    *(uint2*)(ckv + (size_t)row * CKV + lane * 4) = o;
}

__global__ __launch_bounds__(256) void k_scores(const bf16_t* __restrict__ qidx, const bf16_t* __restrict__ kidx, const float* __restrict__ widx, float* __restrict__ sc) {
    __shared__ float sq[IH * IDIM]; __shared__ float sw[IH];
    const int b = blockIdx.y, t = blockIdx.x, rq = rid(b, t);
    for (int i = threadIdx.x; i < IH * IDIM; i += 256) sq[i] = bf2f(qidx[(size_t)rq * 1024 + i]);
    if (threadIdx.x < IH) sw[threadIdx.x] = widx[(size_t)rq * IH + threadIdx.x];
    __syncthreads();
    for (int s = threadIdx.x; s <= t; s += 256) {
        const bf16_t* kp = kidx + (size_t)rid(b, s) * IDIM; float k[IDIM];
#pragma unroll
        for (int i = 0; i < IDIM; i += 8) { const u32x4 w = *(const u32x4*)(kp + i);
            k[i] = __builtin_bit_cast(float, w.x << 16); k[i + 1] = __builtin_bit_cast(float, w.x & 0xffff0000u);
            k[i + 2] = __builtin_bit_cast(float, w.y << 16); k[i + 3] = __builtin_bit_cast(float, w.y & 0xffff0000u);
            k[i + 4] = __builtin_bit_cast(float, w.z << 16); k[i + 5] = __builtin_bit_cast(float, w.z & 0xffff0000u);
            k[i + 6] = __builtin_bit_cast(float, w.w << 16); k[i + 7] = __builtin_bit_cast(float, w.w & 0xffff0000u); }
        float score = 0.f;
        for (int h = 0; h < IH; ++h) { float d = 0.f;
#pragma unroll
            for (int i = 0; i < IDIM; ++i) d = fmaf(sq[h * IDIM + i], k[i], d);
            score = fmaf(sw[h], fmaxf(d, 0.f), score); }
        sc[((size_t)b * T + t) * SCP + s] = score;
    }
}

__device__ __forceinline__ unsigned fkey(float f) { const unsigned u = __builtin_bit_cast(unsigned, f); return (u & 0x80000000u) ? ~u : (u | 0x80000000u); }
__global__ __launch_bounds__(256) void k_topk(const float* __restrict__ sc, unsigned* __restrict__ mask) {
    const int gw = blockIdx.x * 4 + (threadIdx.x >> 6), lane = threadIdx.x & 63; if (gw >= BATCH * T) return;
    const int b = gw / T, t = gw % T, n = t + 1; unsigned* mrow = mask + (size_t)rid(b, t) * MW;
    if (b > 0 && t < N_META) return;
    constexpr int NI = (T + 63) / 64;
    if (n <= TOPK) {
        for (int i = 0; i < NI; ++i) { const int s = i * 64 + lane; const unsigned long long m = __ballot(s <= t);
            if (lane == 0) { mrow[2 * i] = (unsigned)m; mrow[2 * i + 1] = (unsigned)(m >> 32); } }
        if (lane < MW - 2 * NI) mrow[2 * NI + lane] = 0u;
        return;
    }
    unsigned key[NI]; const float* srow = sc + ((size_t)b * T + t) * SCP;
#pragma unroll
    for (int i = 0; i < NI; ++i) { const int s = i * 64 + lane; key[i] = (s <= t) ? fkey(srow[s]) : 0u; }
    unsigned thr = 0u;
    for (int bit = 31; bit >= 0; --bit) {
        const unsigned cand = thr | (1u << bit); int c = 0;
#pragma unroll
        for (int i = 0; i < NI; ++i) c += (key[i] >= cand) ? 1 : 0;
#pragma unroll
        for (int o = 1; o < 64; o <<= 1) c += __shfl_xor(c, o);
        if (c >= TOPK) thr = cand;
    }
    int cgt = 0;
#pragma unroll
    for (int i = 0; i < NI; ++i) cgt += (key[i] > thr) ? 1 : 0;
#pragma unroll
    for (int o = 1; o < 64; o <<= 1) cgt += __shfl_xor(cgt, o);
    int need = TOPK - cgt;
#pragma unroll
    for (int i = 0; i < NI; ++i) {
        const bool eq = key[i] == thr; const unsigned long long em = __ballot(eq);
        const int before = __popcll(em & ((1ull << lane) - 1ull));
        const bool sel = (key[i] > thr) || (eq && before < need);
        need -= __popcll(em); if (need < 0) need = 0;
        const unsigned long long m = __ballot(sel);
        if (lane == 0) { mrow[2 * i] = (unsigned)m; mrow[2 * i + 1] = (unsigned)(m >> 32); }
    }
    if (lane < MW - 2 * NI) mrow[2 * NI + lane] = 0u;
}

__global__ __launch_bounds__(256) void k_attn(const bf16_t* __restrict__ qabs, const bf16_t* __restrict__ ckv, const unsigned* __restrict__ mask,
                                               const float* __restrict__ relb, bf16_t* __restrict__ olat) {
    __shared__ int sel[TOPK]; __shared__ float sqa[NH * CKV]; __shared__ float sp[NH][TOPK]; __shared__ float red[8]; __shared__ int woff[72]; __shared__ int cnt;
    const int b = blockIdx.y, t = blockIdx.x, tid = threadIdx.x, rq = rid(b, t);
    if (b > 0 && t < N_META) return;
    const unsigned* mrow = mask + (size_t)rq * MW;
    for (int i = tid; i < NH * CKV; i += 256) sqa[i] = bf2f(qabs[(size_t)rq * (NH * CKV) + i]);
    if (tid < 65) woff[tid] = __popc(mrow[tid]);
    __syncthreads();
    if (tid == 0) { int a = 0; for (int i = 0; i < 65; ++i) { const int c = woff[i]; woff[i] = a; a += c; } cnt = a; }
    __syncthreads();
    if (tid < 65) { unsigned w = mrow[tid]; int p = woff[tid]; while (w) { const int bit = __ffs((int)w) - 1; w &= w - 1; if (p < TOPK) sel[p] = tid * 32 + bit; ++p; } }
    __syncthreads();
    const int ns = cnt < TOPK ? cnt : TOPK;
    const int s = tid < ns ? sel[tid] : 0; const bf16_t* kp = ckv + (size_t)rid(b, s) * CKV;
    float lg[NH];
#pragma unroll
    for (int h = 0; h < NH; ++h) lg[h] = 0.f;
    for (int c = 0; c < CKV; c += 8) { const u32x4 w = *(const u32x4*)(kp + c); float kv[8];
        kv[0] = __builtin_bit_cast(float, w.x << 16); kv[1] = __builtin_bit_cast(float, w.x & 0xffff0000u); kv[2] = __builtin_bit_cast(float, w.y << 16); kv[3] = __builtin_bit_cast(float, w.y & 0xffff0000u);
        kv[4] = __builtin_bit_cast(float, w.z << 16); kv[5] = __builtin_bit_cast(float, w.z & 0xffff0000u); kv[6] = __builtin_bit_cast(float, w.w << 16); kv[7] = __builtin_bit_cast(float, w.w & 0xffff0000u);
#pragma unroll
        for (int h = 0; h < NH; ++h)
#pragma unroll
            for (int j = 0; j < 8; ++j) lg[h] = fmaf(sqa[h * CKV + c + j], kv[j], lg[h]); }
    int dist = t - s; if (dist < 0) dist = 0; const int bk = dist < 128 ? T5_BUCKET[dist] : 31;
    const int lane = tid & 63, wid = tid >> 6;
    for (int h = 0; h < NH; ++h) {
        float x = tid < ns ? lg[h] * 0.08838834764831845f + relb[bk * NH + h] : -INFINITY;
        float m = x;
#pragma unroll
        for (int o = 1; o < 64; o <<= 1) m = fmaxf(m, __shfl_xor(m, o));
        if (lane == 0) red[wid] = m; __syncthreads();
        m = fmaxf(fmaxf(red[0], red[1]), fmaxf(red[2], red[3])); __syncthreads();
        const float e = tid < ns ? __expf(x - m) : 0.f; float sum = e;
#pragma unroll
        for (int o = 1; o < 64; o <<= 1) sum += __shfl_xor(sum, o);
        if (lane == 0) red[4 + wid] = sum; __syncthreads();
        sum = (red[4] + red[5]) + (red[6] + red[7]);
        sp[h][tid] = e / sum; __syncthreads();
    }
    float o[NH];
#pragma unroll
    for (int h = 0; h < NH; ++h) o[h] = 0.f;
    for (int k = 0; k < ns; ++k) { const float v = bf2f(ckv[(size_t)rid(b, sel[k]) * CKV + tid]);
#pragma unroll
        for (int h = 0; h < NH; ++h) o[h] = fmaf(sp[h][k], v, o[h]); }
#pragma unroll
    for (int h = 0; h < NH; ++h) olat[(size_t)rq * (NH * CKV) + h * CKV + tid] = (bf16_t)f2bf(o[h]);
}

__global__ void k_pooldiff(const float* __restrict__ u, bf16_t* __restrict__ diff) {
    const int t = blockIdx.x, b = blockIdx.y; if (b > 0 && t < N_META) return;
    for (int c = threadIdx.x; c < POOLW; c += blockDim.x) {
        const int w = 2 << (c / PG); const int cntw = (t + 1) < w ? (t + 1) : w; float s = 0.f;
        for (int i = cntw - 1; i >= 0; --i) s += u[(size_t)rid(b, t - i) * POOLW + c];
        const float cur = u[(size_t)rid(b, t) * POOLW + c];
        diff[(size_t)rid(b, t) * POOLW + c] = (bf16_t)f2bf(s / (float)cntw - cur);
    }
}

__global__ __launch_bounds__(256) void k_ln1(const float* __restrict__ x, const float* __restrict__ meta, const float* __restrict__ mix, const float* __restrict__ g,
                                             const float* __restrict__ bb, float* __restrict__ h1, bf16_t* __restrict__ h1f) {
    const int row = blockIdx.x, tid = threadIdx.x; __shared__ float red[8];
    const float* h0 = row < RREAL ? x + (size_t)row * D_MODEL : meta + (size_t)(row - RREAL) * D_MODEL;
    float v[8]; float s = 0.f;
#pragma unroll
    for (int j = 0; j < 2; ++j) { const int c = (tid + j * 256) * 4; const float4 a = *(const float4*)(h0 + c), m = *(const float4*)(mix + (size_t)row * D_MODEL + c);
        v[j * 4 + 0] = ALPHA * a.x + m.x; v[j * 4 + 1] = ALPHA * a.y + m.y; v[j * 4 + 2] = ALPHA * a.z + m.z; v[j * 4 + 3] = ALPHA * a.w + m.w;
        s += (v[j * 4] + v[j * 4 + 1]) + (v[j * 4 + 2] + v[j * 4 + 3]); }
#pragma unroll
    for (int o = 1; o < 64; o <<= 1) s += __shfl_xor(s, o);
    if ((tid & 63) == 0) red[tid >> 6] = s; __syncthreads();
    const float mean = ((red[0] + red[1]) + (red[2] + red[3])) * (1.0f / D_MODEL); __syncthreads();
    float q = 0.f;
#pragma unroll
    for (int j = 0; j < 8; ++j) { v[j] -= mean; q += v[j] * v[j]; }
#pragma unroll
    for (int o = 1; o < 64; o <<= 1) q += __shfl_xor(q, o);
    if ((tid & 63) == 0) red[4 + (tid >> 6)] = q; __syncthreads();
    const float rstd = 1.0f / sqrtf(((red[4] + red[5]) + (red[6] + red[7])) * (1.0f / D_MODEL) + LN_EPS);
#pragma unroll
    for (int j = 0; j < 2; ++j) { const int c = (tid + j * 256) * 4; const float4 gg = *(const float4*)(g + c), be = *(const float4*)(bb + c);
        float4 o; o.x = v[j * 4] * rstd * gg.x + be.x; o.y = v[j * 4 + 1] * rstd * gg.y + be.y; o.z = v[j * 4 + 2] * rstd * gg.z + be.z; o.w = v[j * 4 + 3] * rstd * gg.w + be.w;
        uint2 ob; ob.x = f2bf(o.x) | (f2bf(o.y) << 16); ob.y = f2bf(o.z) | (f2bf(o.w) << 16);
        if (row < RREAL) { *(float4*)(h1 + (size_t)row * D_MODEL + c) = o; const int b = row / SEQ, i = row % SEQ; *(uint2*)(h1f + ((size_t)b * 2050 + 2 + i) * D_MODEL + c) = ob; }
        else { const int tm = row - RREAL; if (tm >= 14) for (int b = 0; b < BATCH; ++b) *(uint2*)(h1f + ((size_t)b * 2050 + (tm - 14)) * D_MODEL + c) = ob; } }
}

__device__ __forceinline__ float gelu_tanh(float x) { const float u = 0.7978845608028654f * (x + 0.044715f * x * x * x); return 0.5f * x * (1.0f + tanhf(u)); }
__global__ void k_convglu(const float* __restrict__ z, const float* __restrict__ cw, const float* __restrict__ cb, bf16_t* __restrict__ act, int nrows) {
    const int i = blockIdx.x;
    for (int n = threadIdx.x; n < D_FF; n += blockDim.x) {
        float a = cb[n], gt = cb[D_FF + n];
#pragma unroll
        for (int j = 0; j < 3; ++j) { a = fmaf(z[(size_t)(i + j) * (2 * D_FF) + n], cw[j * 2 * D_FF + n], a); gt = fmaf(z[(size_t)(i + j) * (2 * D_FF) + D_FF + n], cw[j * 2 * D_FF + D_FF + n], gt); }
        act[(size_t)i * D_FF + n] = (bf16_t)f2bf(gelu_tanh(a) * gt);
    }
}
__global__ __launch_bounds__(256) void k_ln2(const float* __restrict__ h1, const float* __restrict__ f, const float* __restrict__ g, const float* __restrict__ bb, float* __restrict__ out) {
    const int row = blockIdx.x, tid = threadIdx.x; __shared__ float red[8];
    float v[8]; float s = 0.f;
#pragma unroll
    for (int j = 0; j < 2; ++j) { const int c = (tid + j * 256) * 4; const float4 a = *(const float4*)(h1 + (size_t)row * D_MODEL + c), m = *(const float4*)(f + (size_t)row * D_MODEL + c);
        v[j * 4 + 0] = ALPHA * a.x + m.x; v[j * 4 + 1] = ALPHA * a.y + m.y; v[j * 4 + 2] = ALPHA * a.z + m.z; v[j * 4 + 3] = ALPHA * a.w + m.w;
        s += (v[j * 4] + v[j * 4 + 1]) + (v[j * 4 + 2] + v[j * 4 + 3]); }
#pragma unroll
    for (int o = 1; o < 64; o <<= 1) s += __shfl_xor(s, o);
    if ((tid & 63) == 0) red[tid >> 6] = s; __syncthreads();
    const float mean = ((red[0] + red[1]) + (red[2] + red[3])) * (1.0f / D_MODEL); __syncthreads();
    float q = 0.f;
#pragma unroll
    for (int j = 0; j < 8; ++j) { v[j] -= mean; q += v[j] * v[j]; }
#pragma unroll
    for (int o = 1; o < 64; o <<= 1) q += __shfl_xor(q, o);
    if ((tid & 63) == 0) red[4 + (tid >> 6)] = q; __syncthreads();
    const float rstd = 1.0f / sqrtf(((red[4] + red[5]) + (red[6] + red[7])) * (1.0f / D_MODEL) + LN_EPS);
#pragma unroll
    for (int j = 0; j < 2; ++j) { const int c = (tid + j * 256) * 4; const float4 gg = *(const float4*)(g + c), be = *(const float4*)(bb + c);
        float4 o; o.x = v[j * 4] * rstd * gg.x + be.x; o.y = v[j * 4 + 1] * rstd * gg.y + be.y; o.z = v[j * 4 + 2] * rstd * gg.z + be.z; o.w = v[j * 4 + 3] * rstd * gg.w + be.w;
        *(float4*)(out + (size_t)row * D_MODEL + c) = o; }
}

constexpr size_t al(size_t x) { return (x + 255) & ~(size_t)255; }
constexpr size_t O_WIN = 0;
constexpr size_t O_WO = O_WIN + al((size_t)PROJ_PAD * D_MODEL * 2);
constexpr size_t O_WUP = O_WO + al((size_t)D_MODEL * D_MODEL * 2);
constexpr size_t O_WDN = O_WUP + al((size_t)2 * D_FF * D_MODEL * 2);
constexpr size_t O_WUK = O_WDN + al((size_t)D_MODEL * D_FF * 2);
constexpr size_t O_WUVT = O_WUK + al((size_t)CKV * 1024 * 2);
constexpr size_t O_WPT = O_WUVT + al((size_t)1024 * CKV * 2);
constexpr size_t O_E = O_WPT + al((size_t)4 * PG * PG * 2);
constexpr size_t O_HB = O_E;
constexpr size_t O_Q = O_HB + al((size_t)R * D_MODEL * 2);
constexpr size_t O_CKVRAW = O_Q + al((size_t)R * 1024 * 2);
constexpr size_t O_QIDX = O_CKVRAW + al((size_t)R * CKV * 4);
constexpr size_t O_KIDX = O_QIDX + al((size_t)R * 1024 * 2);
constexpr size_t O_WIDX = O_KIDX + al((size_t)R * IDIM * 2);
constexpr size_t O_U = O_WIDX + al((size_t)R * IH * 4);
constexpr size_t O_CKV = O_U + al((size_t)R * POOLW * 4);
constexpr size_t O_QABS = O_CKV + al((size_t)R * CKV * 2);
constexpr size_t O_MASK = O_QABS + al((size_t)R * NH * CKV * 2);
constexpr size_t O_T1 = O_MASK + al((size_t)R * MW * 4);
constexpr size_t O_SC = O_T1;
constexpr size_t O_OLAT = O_T1;
constexpr size_t O_DIFF = O_OLAT + al((size_t)R * NH * CKV * 2);
constexpr size_t O_CAT = O_DIFF + al((size_t)R * POOLW * 2);
constexpr size_t T1_END = O_CAT + al((size_t)R * D_MODEL * 2);
static_assert(O_SC + (size_t)BATCH * T * SCP * 4 <= T1_END, "scores fit T1");
constexpr size_t O_MIX = O_HB;
static_assert(O_MIX + (size_t)R * D_MODEL * 4 <= O_KIDX, "mix fits");
constexpr size_t O_H1 = O_T1;
static_assert(O_H1 + (size_t)RREAL * D_MODEL * 4 <= T1_END, "h1 fits");
constexpr size_t O_H1F = O_U;
static_assert((size_t)BATCH * 2050 * D_MODEL * 2 <= (size_t)R * POOLW * 4, "h1f fits");
constexpr int FCH = 512;
constexpr size_t O_Z = O_QABS;
constexpr size_t O_ACT = O_Z + al((size_t)(FCH + 2) * 2 * D_FF * 4);
constexpr size_t O_F = O_ACT + al((size_t)FCH * D_FF * 2);
static_assert(O_F + (size_t)FCH * D_MODEL * 4 <= O_MASK, "ffn chunk fits");
constexpr size_t WS_NEED = T1_END;
static_assert(WS_NEED <= (size_t)352 * 1024 * 1024, "workspace budget");

template <class Epi> static void gemm(hipStream_t st, const bf16_t* A, const bf16_t* Bt, int M, int N, int K, int lda, int ldb, size_t zA, size_t zB, int nz, Epi e) {
    GemmP g{A, Bt, zA, zB, M, N, K, lda, ldb, 0};
    dim3 grid((N + 127) / 128, (M + 127) / 128, nz);
    hipLaunchKernelGGL(k_gemm<Epi>, grid, dim3(256), 0, st, g, e);
}

extern "C" void kernel_launch(void* const* d_in, const int* in_sizes, int n_in, void* d_out, int out_size, void* d_ws, size_t ws_size, hipStream_t stream) {
    if (ws_size < WS_NEED) { fprintf(stderr, "kernel_launch: workspace too small: %zu < %zu\n", ws_size, (size_t)WS_NEED); return; }
    const float* x = (const float*)d_in[0]; const float* meta = (const float*)d_in[1]; const float* relb = (const float*)d_in[2]; const float* w_in = (const float*)d_in[3];
    const float* kvg = (const float*)d_in[4]; const float* w_uk = (const float*)d_in[5]; const float* w_uv = (const float*)d_in[6]; const float* w_pool = (const float*)d_in[7];
    const float* pscale = (const float*)d_in[8]; const float* w_o = (const float*)d_in[9]; const float* ln1g = (const float*)d_in[10]; const float* ln1b = (const float*)d_in[11];
    const float* w_up = (const float*)d_in[12]; const float* convw = (const float*)d_in[13]; const float* convb = (const float*)d_in[14]; const float* w_dn = (const float*)d_in[15];
    const float* ln2g = (const float*)d_in[16]; const float* ln2b = (const float*)d_in[17];
    char* ws = (char*)d_ws; float* out = (float*)d_out;
    bf16_t *WinT = (bf16_t*)(ws + O_WIN), *WoT = (bf16_t*)(ws + O_WO), *WupT = (bf16_t*)(ws + O_WUP), *WdnT = (bf16_t*)(ws + O_WDN), *wukb = (bf16_t*)(ws + O_WUK), *wuvT = (bf16_t*)(ws + O_WUVT), *wpT = (bf16_t*)(ws + O_WPT);
    bf16_t *hb = (bf16_t*)(ws + O_HB), *q = (bf16_t*)(ws + O_Q), *qidx = (bf16_t*)(ws + O_QIDX), *kidx = (bf16_t*)(ws + O_KIDX), *ckv = (bf16_t*)(ws + O_CKV), *qabs = (bf16_t*)(ws + O_QABS);
    float *ckvraw = (float*)(ws + O_CKVRAW), *widx = (float*)(ws + O_WIDX), *u = (float*)(ws + O_U), *sc = (float*)(ws + O_SC), *mix = (float*)(ws + O_MIX), *h1 = (float*)(ws + O_H1);
    unsigned* mask = (unsigned*)(ws + O_MASK);
    bf16_t *olat = (bf16_t*)(ws + O_OLAT), *diff = (bf16_t*)(ws + O_DIFF), *cat = (bf16_t*)(ws + O_CAT), *h1f = (bf16_t*)(ws + O_H1F), *act = (bf16_t*)(ws + O_ACT);
    float *zc = (float*)(ws + O_Z), *fc = (float*)(ws + O_F);

    hipLaunchKernelGGL(k_rows_bf16, dim3(2048), dim3(256), 0, stream, x, meta, hb);
    hipLaunchKernelGGL(k_transpose, dim3(PROJ_PAD / 32, D_MODEL / 32), dim3(256), 0, stream, w_in, WinT, D_MODEL, PROJ, PROJ_PAD);
    hipLaunchKernelGGL(k_transpose, dim3(D_MODEL / 32, D_MODEL / 32), dim3(256), 0, stream, w_o, WoT, D_MODEL, D_MODEL, D_MODEL);
    hipLaunchKernelGGL(k_transpose, dim3(2 * D_FF / 32, D_MODEL / 32), dim3(256), 0, stream, w_up, WupT, D_MODEL, 2 * D_FF, 2 * D_FF);
    hipLaunchKernelGGL(k_transpose, dim3(D_MODEL / 32, D_FF / 32), dim3(256), 0, stream, w_dn, WdnT, D_FF, D_MODEL, D_MODEL);
    hipLaunchKernelGGL(k_cvt, dim3(256), dim3(256), 0, stream, w_uk, wukb, (size_t)CKV * 1024);
    hipLaunchKernelGGL(k_transpose, dim3(1024 / 32, CKV / 32), dim3(256), 0, stream, w_uv, wuvT, CKV, 1024, 1024);
    for (int g = 0; g < 4; ++g) hipLaunchKernelGGL(k_transpose, dim3(PG / 32, PG / 32), dim3(256), 0, stream, w_pool + (size_t)g * PG * PG, wpT + (size_t)g * PG * PG, PG, PG, PG);
    gemm(stream, hb, WinT, R, PROJ_PAD, D_MODEL, D_MODEL, D_MODEL, 0, 0, 1, EpiProj{q, ckvraw, qidx, kidx, widx, u});
    hipLaunchKernelGGL(k_rmsnorm, dim3((R + 3) / 4), dim3(256), 0, stream, ckvraw, kvg, ckv);
    gemm(stream, q, wukb, R, CKV, HD, 1024, 1024, (size_t)HD, (size_t)HD, NH, EpiBf16Z{qabs, nullptr, (size_t)CKV, NH * CKV, 0});
    hipLaunchKernelGGL(k_scores, dim3(T, BATCH), dim3(256), 0, stream, qidx, kidx, widx, sc);
    hipLaunchKernelGGL(k_topk, dim3((BATCH * T + 3) / 4), dim3(256), 0, stream, sc, mask);
    hipLaunchKernelGGL(k_attn, dim3(T, BATCH), dim3(256), 0, stream, qabs, ckv, mask, relb, olat);
    gemm(stream, olat, wuvT, R, HD, CKV, NH * CKV, CKV, (size_t)CKV, (size_t)HD * CKV, NH, EpiBf16Z{cat, nullptr, (size_t)HD, D_MODEL, 0});
    hipLaunchKernelGGL(k_pooldiff, dim3(T, BATCH), dim3(256), 0, stream, u, diff);
    gemm(stream, diff, wpT, R, PG, PG, POOLW, PG, (size_t)PG, (size_t)PG * PG, 4, EpiBf16Z{cat + 1024, pscale, (size_t)PG, D_MODEL, PG});
    gemm(stream, cat, WoT, R, D_MODEL, D_MODEL, D_MODEL, D_MODEL, 0, 0, 1, EpiF32{mix, D_MODEL, 0});
    hipLaunchKernelGGL(k_ln1, dim3(R), dim3(256), 0, stream, x, meta, mix, ln1g, ln1b, h1, h1f);
    for (int b = 0; b < BATCH; ++b)
        for (int c0 = 0; c0 < SEQ; c0 += FCH) {
            const bf16_t* Ain = h1f + ((size_t)b * 2050 + c0) * D_MODEL;
            gemm(stream, Ain, WupT, FCH + 2, 2 * D_FF, D_MODEL, D_MODEL, D_MODEL, 0, 0, 1, EpiF32{zc, 2 * D_FF, 0});
            hipLaunchKernelGGL(k_convglu, dim3(FCH), dim3(256), 0, stream, zc, convw, convb, act, FCH);
            gemm(stream, act, WdnT, FCH, D_MODEL, D_FF, D_FF, D_FF, 0, 0, 1, EpiF32{fc, D_MODEL, 0});
            const size_t r0 = (size_t)b * SEQ + c0;
            hipLaunchKernelGGL(k_ln2, dim3(FCH), dim3(256), 0, stream, h1 + r0 * D_MODEL, fc, ln2g, ln2b, out + r0 * D_MODEL);
        }
}
```

```cpp
#include <hip/hip_runtime.h>
#include <cstdint>
#include <cstdio>

typedef unsigned short bf16_t;
typedef short bf16x8 __attribute__((ext_vector_type(8)));
typedef float f32x4 __attribute__((ext_vector_type(4)));
typedef unsigned u32x4 __attribute__((ext_vector_type(4)));

constexpr int D_MODEL = 2048, BATCH = 4, SEQ = 2048, N_META = 16, T = SEQ + N_META;
constexpr int NH = 8, HD = 128, CKV = 256, IH = 16, IDIM = 64, TOPK = 256;
constexpr int POOLW = 1024, PG = 256, D_FF = 5632;
constexpr int PROJ = 3408, PROJ_PAD = 3584;
constexpr int C_Q = 0, C_CKV = 1024, C_QI = 1280, C_KI = 2304, C_WI = 2368, C_U = 2384;
constexpr int R = BATCH * SEQ + N_META;
constexpr int RREAL = BATCH * SEQ;
constexpr float ALPHA = 1.189207115002721f;
constexpr float LN_EPS = 1e-5f;
constexpr int MW = 68;
constexpr int SCP = 2080;

__host__ __device__ __forceinline__ int rid(int b, int t) { return t < N_META ? RREAL + t : b * SEQ + (t - N_META); }

__device__ __forceinline__ unsigned f2bf(float f) { unsigned u = __builtin_bit_cast(unsigned, f); return (u + 0x7fffu + ((u >> 16) & 1u)) >> 16; }
__device__ __forceinline__ float bf2f(bf16_t h) { return __builtin_bit_cast(float, (unsigned)h << 16); }

__device__ const unsigned char T5_BUCKET[128] = {
    0, 1, 2, 3, 4, 5, 6, 7, 8, 9, 10, 11, 12, 13, 14, 15, 16, 16, 16, 17, 17, 18, 18, 18, 19, 19, 19, 20, 20, 20, 20, 21, 21, 21, 21, 22, 22, 22, 22, 22,
    23, 23, 23, 23, 23, 23, 24, 24, 24, 24, 24, 24, 25, 25, 25, 25, 25, 25, 25, 26, 26, 26, 26, 26, 26, 26, 26, 27, 27, 27, 27, 27, 27, 27, 27, 27, 27,
    28, 28, 28, 28, 28, 28, 28, 28, 28, 28, 29, 29, 29, 29, 29, 29, 29, 29, 29, 29, 29, 29, 30, 30, 30, 30, 30, 30, 30, 30, 30, 30, 30, 30, 30, 30,
    31, 31, 31, 31, 31, 31, 31, 31, 31, 31, 31, 31, 31, 31, 31};

__device__ __forceinline__ void k_rows_bf16(const float* __restrict__ x, const float* __restrict__ meta, bf16_t* __restrict__ hb) {
    const size_t n4 = (size_t)R * D_MODEL / 4;
    for (size_t i = (size_t)blockIdx.x * blockDim.x + threadIdx.x; i < n4; i += (size_t)gridDim.x * blockDim.x) {
        const size_t e = i * 4; const int row = (int)(e / D_MODEL), col = (int)(e % D_MODEL);
        const float* src = row < RREAL ? x + (size_t)row * D_MODEL + col : meta + (size_t)(row - RREAL) * D_MODEL + col;
        const float4 v = *(const float4*)src;
        uint2 o; o.x = f2bf(v.x) | (f2bf(v.y) << 16); o.y = f2bf(v.z) | (f2bf(v.w) << 16);
        *(uint2*)(hb + e) = o;
    }
}
__device__ __forceinline__ void k_transpose(const float* __restrict__ W, bf16_t* __restrict__ WT, int K, int N, int NP, int vbx, int vby) {
    __shared__ float tile[32][33];
    const int n0 = vbx * 32, k0 = vby * 32, tx = threadIdx.x & 31, ty = threadIdx.x >> 5;
    for (int i = ty; i < 32; i += 8) { const int k = k0 + i, n = n0 + tx; tile[i][tx] = (k < K && n < N) ? W[(size_t)k * N + n] : 0.f; }
    __syncthreads();
    for (int i = ty; i < 32; i += 8) { const int n = n0 + i, k = k0 + tx; if (n < NP && k < K) WT[(size_t)n * K + k] = (bf16_t)f2bf(tile[tx][i]); }
    __syncthreads();
}
__device__ __forceinline__ void k_cvt(const float* __restrict__ s, bf16_t* __restrict__ d, size_t n) {
    for (size_t i = (size_t)blockIdx.x * blockDim.x + threadIdx.x; i < n; i += (size_t)gridDim.x * blockDim.x) d[i] = (bf16_t)f2bf(s[i]);
}

struct GemmP { const bf16_t* A; const bf16_t* Bt; size_t zA, zB; int M, N, K, lda, ldb, pad; };
template <class Epi>
__device__ __forceinline__ void k_gemm(const GemmP& g, const Epi& epi, int vbx, int vby, int vbz) {
    __shared__ __attribute__((aligned(16))) bf16_t sA[128 * 40];
    __shared__ __attribute__((aligned(16))) bf16_t sB[128 * 40];
    const int tid = threadIdx.x, lane = tid & 63, wid = tid >> 6, wr = wid >> 1, wc = wid & 1, fr = lane & 15, fq = lane >> 4;
    const int z = vbz; const bf16_t* A = g.A + (size_t)z * g.zA; const bf16_t* Bt = g.Bt + (size_t)z * g.zB;
    const int m0 = vby * 128, n0 = vbx * 128;
    f32x4 acc[4][4];
#pragma unroll
    for (int i = 0; i < 4; ++i)
#pragma unroll
        for (int j = 0; j < 4; ++j) acc[i][j] = (f32x4){0.f, 0.f, 0.f, 0.f};
    for (int k0 = 0; k0 < g.K; k0 += 32) {
#pragma unroll
        for (int i = 0; i < 2; ++i) {
            const int ch = tid + i * 256, r = ch >> 2, c = (ch & 3) * 8;
            int ra = m0 + r; if (ra >= g.M) ra = g.M - 1;
            int rb = n0 + r; if (rb >= g.N) rb = g.N - 1;
            *(u32x4*)(sA + r * 40 + c) = *(const u32x4*)(A + (size_t)ra * g.lda + k0 + c);
            *(u32x4*)(sB + r * 40 + c) = *(const u32x4*)(Bt + (size_t)rb * g.ldb + k0 + c);
        }
        __syncthreads();
        bf16x8 af[4], bfr[4];
#pragma unroll
        for (int i = 0; i < 4; ++i) af[i] = *(const bf16x8*)(sA + (wr * 64 + i * 16 + fr) * 40 + fq * 8);
#pragma unroll
        for (int j = 0; j < 4; ++j) bfr[j] = *(const bf16x8*)(sB + (wc * 64 + j * 16 + fr) * 40 + fq * 8);
#pragma unroll
        for (int i = 0; i < 4; ++i)
#pragma unroll
            for (int j = 0; j < 4; ++j) acc[i][j] = __builtin_amdgcn_mfma_f32_16x16x32_bf16(af[i], bfr[j], acc[i][j], 0, 0, 0);
        __syncthreads();
    }
#pragma unroll
    for (int i = 0; i < 4; ++i)
#pragma unroll
        for (int j = 0; j < 4; ++j)
#pragma unroll
            for (int e = 0; e < 4; ++e) {
                const int row = m0 + wr * 64 + i * 16 + fq * 4 + e, col = n0 + wc * 64 + j * 16 + fr;
                if (row < g.M && col < g.N) epi(row, col, acc[i][j][e], z);
            }
}
struct EpiProj {
    bf16_t* q; float* ckvraw; bf16_t* qidx; bf16_t* kidx; float* widx; float* u;
    __device__ __forceinline__ void operator()(int row, int col, float v, int) const {
        if (col < C_CKV) q[(size_t)row * 1024 + col] = (bf16_t)f2bf(v);
        else if (col < C_QI) ckvraw[(size_t)row * CKV + (col - C_CKV)] = v;
        else if (col < C_KI) qidx[(size_t)row * 1024 + (col - C_QI)] = (bf16_t)f2bf(v * 0.125f);
        else if (col < C_WI) kidx[(size_t)row * IDIM + (col - C_KI)] = (bf16_t)f2bf(v);
        else if (col < C_U) widx[(size_t)row * IH + (col - C_WI)] = v * 0.25f;
        else if (col < PROJ) u[(size_t)row * POOLW + (col - C_U)] = v;
    }
};
struct EpiBf16Z { bf16_t* C; const float* scale; size_t zC; int ldc; int zscale;
    __device__ __forceinline__ void operator()(int row, int col, float v, int z) const {
        if (scale) v *= scale[z * zscale + col];
        C[(size_t)z * zC + (size_t)row * ldc + col] = (bf16_t)f2bf(v); } };
struct EpiF32 { float* C; int ldc; int pad;
    __device__ __forceinline__ void operator()(int row, int col, float v, int) const { C[(size_t)row * ldc + col] = v; } };

__device__ __forceinline__ void k_rmsnorm(const float* __restrict__ raw, const float* __restrict__ g, bf16_t* __restrict__ ckv, int vb) {
    const int row = vb * 4 + (threadIdx.x >> 6), lane = threadIdx.x & 63; if (row >= R) return;
    const float4 v = *(const float4*)(raw + (size_t)row * CKV + lane * 4);
    float s = v.x * v.x + v.y * v.y + v.z * v.z + v.w * v.w;
#pragma unroll
    for (int o = 1; o < 64; o <<= 1) s += __shfl_xor(s, o);
    const float r = 1.0f / sqrtf(s * (1.0f / CKV) + LN_EPS);
    const float4 gg = *(const float4*)(g + lane * 4);
    uint2 o; o.x = f2bf(v.x * r * gg.x) | (f2bf(v.y * r * gg.y) << 16); o.y = f2bf(v.z * r * gg.z) | (f2bf(v.w * r * gg.w) << 16);
    *(uint2*)(ckv + (size_t)row * CKV + lane * 4) = o;
}

__device__ __forceinline__ void k_scores(const bf16_t* __restrict__ qidx, const bf16_t* __restrict__ kidx, const float* __restrict__ widx, float* __restrict__ sc, int vbx, int vby) {
    __shared__ float sq[IH * IDIM]; __shared__ float sw[IH];
    const int b = vby, t = vbx, rq = rid(b, t);
    for (int i = threadIdx.x; i < IH * IDIM; i += 256) sq[i] = bf2f(qidx[(size_t)rq * 1024 + i]);
    if (threadIdx.x < IH) sw[threadIdx.x] = widx[(size_t)rq * IH + threadIdx.x];
    __syncthreads();
    for (int s = threadIdx.x; s <= t; s += 256) {
        const bf16_t* kp = kidx + (size_t)rid(b, s) * IDIM; float k[IDIM];
#pragma unroll
        for (int i = 0; i < IDIM; i += 8) { const u32x4 w = *(const u32x4*)(kp + i);
            k[i] = __builtin_bit_cast(float, w.x << 16); k[i + 1] = __builtin_bit_cast(float, w.x & 0xffff0000u);
            k[i + 2] = __builtin_bit_cast(float, w.y << 16); k[i + 3] = __builtin_bit_cast(float, w.y & 0xffff0000u);
            k[i + 4] = __builtin_bit_cast(float, w.z << 16); k[i + 5] = __builtin_bit_cast(float, w.z & 0xffff0000u);
            k[i + 6] = __builtin_bit_cast(float, w.w << 16); k[i + 7] = __builtin_bit_cast(float, w.w & 0xffff0000u); }
        float score = 0.f;
        for (int h = 0; h < IH; ++h) { float d = 0.f;
#pragma unroll
            for (int i = 0; i < IDIM; ++i) d = fmaf(sq[h * IDIM + i], k[i], d);
            score = fmaf(sw[h], fmaxf(d, 0.f), score); }
        sc[((size_t)b * T + t) * SCP + s] = score;
    }
    __syncthreads();
}

__device__ __forceinline__ unsigned fkey(float f) { const unsigned u = __builtin_bit_cast(unsigned, f); return (u & 0x80000000u) ? ~u : (u | 0x80000000u); }
__device__ __forceinline__ void k_topk(const float* __restrict__ sc, unsigned* __restrict__ mask, int vb) {
    const int gw = vb * 4 + (threadIdx.x >> 6), lane = threadIdx.x & 63; if (gw >= BATCH * T) return;
    const int b = gw / T, t = gw % T, n = t + 1; unsigned* mrow = mask + (size_t)rid(b, t) * MW;
    if (b > 0 && t < N_META) return;
    constexpr int NI = (T + 63) / 64;
    if (n <= TOPK) {
        for (int i = 0; i < NI; ++i) { const int s = i * 64 + lane; const unsigned long long m = __ballot(s <= t);
            if (lane == 0) { mrow[2 * i] = (unsigned)m; mrow[2 * i + 1] = (unsigned)(m >> 32); } }
        if (lane < MW - 2 * NI) mrow[2 * NI + lane] = 0u;
        return;
    }
    unsigned key[NI]; const float* srow = sc + ((size_t)b * T + t) * SCP;
#pragma unroll
    for (int i = 0; i < NI; ++i) { const int s = i * 64 + lane; key[i] = (s <= t) ? fkey(srow[s]) : 0u; }
    unsigned thr = 0u;
    for (int bit = 31; bit >= 0; --bit) {
        const unsigned cand = thr | (1u << bit); int c = 0;
#pragma unroll
        for (int i = 0; i < NI; ++i) c += (key[i] >= cand) ? 1 : 0;
#pragma unroll
        for (int o = 1; o < 64; o <<= 1) c += __shfl_xor(c, o);
        if (c >= TOPK) thr = cand;
    }
    int cgt = 0;
#pragma unroll
    for (int i = 0; i < NI; ++i) cgt += (key[i] > thr) ? 1 : 0;
#pragma unroll
    for (int o = 1; o < 64; o <<= 1) cgt += __shfl_xor(cgt, o);
    int need = TOPK - cgt;
#pragma unroll
    for (int i = 0; i < NI; ++i) {
        const bool eq = key[i] == thr; const unsigned long long em = __ballot(eq);
        const int before = __popcll(em & ((1ull << lane) - 1ull));
        const bool sel = (key[i] > thr) || (eq && before < need);
        need -= __popcll(em); if (need < 0) need = 0;
        const unsigned long long m = __ballot(sel);
        if (lane == 0) { mrow[2 * i] = (unsigned)m; mrow[2 * i + 1] = (unsigned)(m >> 32); }
    }
    if (lane < MW - 2 * NI) mrow[2 * NI + lane] = 0u;
}

__device__ __forceinline__ void k_attn(const bf16_t* __restrict__ qabs, const bf16_t* __restrict__ ckv, const unsigned* __restrict__ mask,
                                               const float* __restrict__ relb, bf16_t* __restrict__ olat, int vbx, int vby) {
    __shared__ int sel[TOPK]; __shared__ float sqa[NH * CKV]; __shared__ float sp[NH][TOPK]; __shared__ float red[8]; __shared__ int woff[72]; __shared__ int cnt;
    const int b = vby, t = vbx, tid = threadIdx.x, rq = rid(b, t);
    if (b > 0 && t < N_META) return;
    __syncthreads();
    const unsigned* mrow = mask + (size_t)rq * MW;
    for (int i = tid; i < NH * CKV; i += 256) sqa[i] = bf2f(qabs[(size_t)rq * (NH * CKV) + i]);
    if (tid < 65) woff[tid] = __popc(mrow[tid]);
    __syncthreads();
    if (tid == 0) { int a = 0; for (int i = 0; i < 65; ++i) { const int c = woff[i]; woff[i] = a; a += c; } cnt = a; }
    __syncthreads();
    if (tid < 65) { unsigned w = mrow[tid]; int p = woff[tid]; while (w) { const int bit = __ffs((int)w) - 1; w &= w - 1; if (p < TOPK) sel[p] = tid * 32 + bit; ++p; } }
    __syncthreads();
    const int ns = cnt < TOPK ? cnt : TOPK;
    const int s = tid < ns ? sel[tid] : 0; const bf16_t* kp = ckv + (size_t)rid(b, s) * CKV;
    float lg[NH];
#pragma unroll
    for (int h = 0; h < NH; ++h) lg[h] = 0.f;
    for (int c = 0; c < CKV; c += 8) { const u32x4 w = *(const u32x4*)(kp + c); float kv[8];
        kv[0] = __builtin_bit_cast(float, w.x << 16); kv[1] = __builtin_bit_cast(float, w.x & 0xffff0000u); kv[2] = __builtin_bit_cast(float, w.y << 16); kv[3] = __builtin_bit_cast(float, w.y & 0xffff0000u);
        kv[4] = __builtin_bit_cast(float, w.z << 16); kv[5] = __builtin_bit_cast(float, w.z & 0xffff0000u); kv[6] = __builtin_bit_cast(float, w.w << 16); kv[7] = __builtin_bit_cast(float, w.w & 0xffff0000u);
#pragma unroll
        for (int h = 0; h < NH; ++h)
#pragma unroll
            for (int j = 0; j < 8; ++j) lg[h] = fmaf(sqa[h * CKV + c + j], kv[j], lg[h]); }
    int dist = t - s; if (dist < 0) dist = 0; const int bk = dist < 128 ? T5_BUCKET[dist] : 31;
    const int lane = tid & 63, wid = tid >> 6;
    for (int h = 0; h < NH; ++h) {
        float x = tid < ns ? lg[h] * 0.08838834764831845f + relb[bk * NH + h] : -INFINITY;
        float m = x;
#pragma unroll
        for (int o = 1; o < 64; o <<= 1) m = fmaxf(m, __shfl_xor(m, o));
        if (lane == 0) red[wid] = m; __syncthreads();
        m = fmaxf(fmaxf(red[0], red[1]), fmaxf(red[2], red[3])); __syncthreads();
        const float e = tid < ns ? __expf(x - m) : 0.f; float sum = e;
#pragma unroll
        for (int o = 1; o < 64; o <<= 1) sum += __shfl_xor(sum, o);
        if (lane == 0) red[4 + wid] = sum; __syncthreads();
        sum = (red[4] + red[5]) + (red[6] + red[7]);
        sp[h][tid] = e / sum; __syncthreads();
    }
    float o[NH];
#pragma unroll
    for (int h = 0; h < NH; ++h) o[h] = 0.f;
    for (int k = 0; k < ns; ++k) { const float v = bf2f(ckv[(size_t)rid(b, sel[k]) * CKV + tid]);
#pragma unroll
        for (int h = 0; h < NH; ++h) o[h] = fmaf(sp[h][k], v, o[h]); }
#pragma unroll
    for (int h = 0; h < NH; ++h) olat[(size_t)rq * (NH * CKV) + h * CKV + tid] = (bf16_t)f2bf(o[h]);
}

__device__ __forceinline__ void k_pooldiff(const float* __restrict__ u, bf16_t* __restrict__ diff, int vbx, int vby) {
    const int t = vbx, b = vby; if (b > 0 && t < N_META) return;
    for (int c = threadIdx.x; c < POOLW; c += blockDim.x) {
        const int w = 2 << (c / PG); const int cntw = (t + 1) < w ? (t + 1) : w; float s = 0.f;
        for (int i = cntw - 1; i >= 0; --i) s += u[(size_t)rid(b, t - i) * POOLW + c];
        const float cur = u[(size_t)rid(b, t) * POOLW + c];
        diff[(size_t)rid(b, t) * POOLW + c] = (bf16_t)f2bf(s / (float)cntw - cur);
    }
}

__device__ __forceinline__ void k_ln1(const float* __restrict__ x, const float* __restrict__ meta, const float* __restrict__ mix, const float* __restrict__ g,
                                             const float* __restrict__ bb, float* __restrict__ h1, bf16_t* __restrict__ h1f, int vb) {
    const int row = vb, tid = threadIdx.x; __shared__ float red[8]; __syncthreads();
    const float* h0 = row < RREAL ? x + (size_t)row * D_MODEL : meta + (size_t)(row - RREAL) * D_MODEL;
    float v[8]; float s = 0.f;
#pragma unroll
    for (int j = 0; j < 2; ++j) { const int c = (tid + j * 256) * 4; const float4 a = *(const float4*)(h0 + c), m = *(const float4*)(mix + (size_t)row * D_MODEL + c);
        v[j * 4 + 0] = ALPHA * a.x + m.x; v[j * 4 + 1] = ALPHA * a.y + m.y; v[j * 4 + 2] = ALPHA * a.z + m.z; v[j * 4 + 3] = ALPHA * a.w + m.w;
        s += (v[j * 4] + v[j * 4 + 1]) + (v[j * 4 + 2] + v[j * 4 + 3]); }
#pragma unroll
    for (int o = 1; o < 64; o <<= 1) s += __shfl_xor(s, o);
    if ((tid & 63) == 0) red[tid >> 6] = s; __syncthreads();
    const float mean = ((red[0] + red[1]) + (red[2] + red[3])) * (1.0f / D_MODEL); __syncthreads();
    float q = 0.f;
#pragma unroll
    for (int j = 0; j < 8; ++j) { v[j] -= mean; q += v[j] * v[j]; }
#pragma unroll
    for (int o = 1; o < 64; o <<= 1) q += __shfl_xor(q, o);
    if ((tid & 63) == 0) red[4 + (tid >> 6)] = q; __syncthreads();
    const float rstd = 1.0f / sqrtf(((red[4] + red[5]) + (red[6] + red[7])) * (1.0f / D_MODEL) + LN_EPS);
#pragma unroll
    for (int j = 0; j < 2; ++j) { const int c = (tid + j * 256) * 4; const float4 gg = *(const float4*)(g + c), be = *(const float4*)(bb + c);
        float4 o; o.x = v[j * 4] * rstd * gg.x + be.x; o.y = v[j * 4 + 1] * rstd * gg.y + be.y; o.z = v[j * 4 + 2] * rstd * gg.z + be.z; o.w = v[j * 4 + 3] * rstd * gg.w + be.w;
        uint2 ob; ob.x = f2bf(o.x) | (f2bf(o.y) << 16); ob.y = f2bf(o.z) | (f2bf(o.w) << 16);
        if (row < RREAL) { *(float4*)(h1 + (size_t)row * D_MODEL + c) = o; const int b = row / SEQ, i = row % SEQ; *(uint2*)(h1f + ((size_t)b * 2050 + 2 + i) * D_MODEL + c) = ob; }
        else { const int tm = row - RREAL; if (tm >= 14) for (int b = 0; b < BATCH; ++b) *(uint2*)(h1f + ((size_t)b * 2050 + (tm - 14)) * D_MODEL + c) = ob; } }
}

__device__ __forceinline__ float gelu_tanh(float x) { const float u = 0.7978845608028654f * (x + 0.044715f * x * x * x); return 0.5f * x * (1.0f + tanhf(u)); }
__device__ __forceinline__ void k_convglu(const float* __restrict__ z, const float* __restrict__ cw, const float* __restrict__ cb, bf16_t* __restrict__ act, int vb) {
    const int i = vb;
    for (int n = threadIdx.x; n < D_FF; n += blockDim.x) {
        float a = cb[n], gt = cb[D_FF + n];
#pragma unroll
        for (int j = 0; j < 3; ++j) { a = fmaf(z[(size_t)(i + j) * (2 * D_FF) + n], cw[j * 2 * D_FF + n], a); gt = fmaf(z[(size_t)(i + j) * (2 * D_FF) + D_FF + n], cw[j * 2 * D_FF + D_FF + n], gt); }
        act[(size_t)i * D_FF + n] = (bf16_t)f2bf(gelu_tanh(a) * gt);
    }
}
__device__ __forceinline__ void k_ln2(const float* __restrict__ h1, const float* __restrict__ f, const float* __restrict__ g, const float* __restrict__ bb, float* __restrict__ out, int vb) {
    const int row = vb, tid = threadIdx.x; __shared__ float red[8]; __syncthreads();
    float v[8]; float s = 0.f;
#pragma unroll
    for (int j = 0; j < 2; ++j) { const int c = (tid + j * 256) * 4; const float4 a = *(const float4*)(h1 + (size_t)row * D_MODEL + c), m = *(const float4*)(f + (size_t)row * D_MODEL + c);
        v[j * 4 + 0] = ALPHA * a.x + m.x; v[j * 4 + 1] = ALPHA * a.y + m.y; v[j * 4 + 2] = ALPHA * a.z + m.z; v[j * 4 + 3] = ALPHA * a.w + m.w;
        s += (v[j * 4] + v[j * 4 + 1]) + (v[j * 4 + 2] + v[j * 4 + 3]); }
#pragma unroll
    for (int o = 1; o < 64; o <<= 1) s += __shfl_xor(s, o);
    if ((tid & 63) == 0) red[tid >> 6] = s; __syncthreads();
    const float mean = ((red[0] + red[1]) + (red[2] + red[3])) * (1.0f / D_MODEL); __syncthreads();
    float q = 0.f;
#pragma unroll
    for (int j = 0; j < 8; ++j) { v[j] -= mean; q += v[j] * v[j]; }
#pragma unroll
    for (int o = 1; o < 64; o <<= 1) q += __shfl_xor(q, o);
    if ((tid & 63) == 0) red[4 + (tid >> 6)] = q; __syncthreads();
    const float rstd = 1.0f / sqrtf(((red[4] + red[5]) + (red[6] + red[7])) * (1.0f / D_MODEL) + LN_EPS);
#pragma unroll
    for (int j = 0; j < 2; ++j) { const int c = (tid + j * 256) * 4; const float4 gg = *(const float4*)(g + c), be = *(const float4*)(bb + c);
        float4 o; o.x = v[j * 4] * rstd * gg.x + be.x; o.y = v[j * 4 + 1] * rstd * gg.y + be.y; o.z = v[j * 4 + 2] * rstd * gg.z + be.z; o.w = v[j * 4 + 3] * rstd * gg.w + be.w;
        *(float4*)(out + (size_t)row * D_MODEL + c) = o; }
}

constexpr size_t al(size_t x) { return (x + 255) & ~(size_t)255; }
constexpr size_t O_WIN = 0;
constexpr size_t O_WO = O_WIN + al((size_t)PROJ_PAD * D_MODEL * 2);
constexpr size_t O_WUP = O_WO + al((size_t)D_MODEL * D_MODEL * 2);
constexpr size_t O_WDN = O_WUP + al((size_t)2 * D_FF * D_MODEL * 2);
constexpr size_t O_WUK = O_WDN + al((size_t)D_MODEL * D_FF * 2);
constexpr size_t O_WUVT = O_WUK + al((size_t)CKV * 1024 * 2);
constexpr size_t O_WPT = O_WUVT + al((size_t)1024 * CKV * 2);
constexpr size_t O_E = O_WPT + al((size_t)4 * PG * PG * 2);
constexpr size_t O_HB = O_E;
constexpr size_t O_Q = O_HB + al((size_t)R * D_MODEL * 2);
constexpr size_t O_CKVRAW = O_Q + al((size_t)R * 1024 * 2);
constexpr size_t O_QIDX = O_CKVRAW + al((size_t)R * CKV * 4);
constexpr size_t O_KIDX = O_QIDX + al((size_t)R * 1024 * 2);
constexpr size_t O_WIDX = O_KIDX + al((size_t)R * IDIM * 2);
constexpr size_t O_U = O_WIDX + al((size_t)R * IH * 4);
constexpr size_t O_CKV = O_U + al((size_t)R * POOLW * 4);
constexpr size_t O_QABS = O_CKV + al((size_t)R * CKV * 2);
constexpr size_t O_MASK = O_QABS + al((size_t)R * NH * CKV * 2);
constexpr size_t O_T1 = O_MASK + al((size_t)R * MW * 4);
constexpr size_t O_SC = O_T1;
constexpr size_t O_OLAT = O_T1;
constexpr size_t O_DIFF = O_OLAT + al((size_t)R * NH * CKV * 2);
constexpr size_t O_CAT = O_DIFF + al((size_t)R * POOLW * 2);
constexpr size_t T1_END = O_CAT + al((size_t)R * D_MODEL * 2);
static_assert(O_SC + (size_t)BATCH * T * SCP * 4 <= T1_END, "scores fit T1");
constexpr size_t O_MIX = O_HB;
static_assert(O_MIX + (size_t)R * D_MODEL * 4 <= O_KIDX, "mix fits");
constexpr size_t O_H1 = O_T1;
static_assert(O_H1 + (size_t)RREAL * D_MODEL * 4 <= T1_END, "h1 fits");
constexpr size_t O_H1F = O_U;
static_assert((size_t)BATCH * 2050 * D_MODEL * 2 <= (size_t)R * POOLW * 4, "h1f fits");
constexpr int FCH = 512;
constexpr size_t O_Z = O_QABS;
constexpr size_t O_ACT = O_Z + al((size_t)(FCH + 2) * 2 * D_FF * 4);
constexpr size_t O_F = O_ACT + al((size_t)FCH * D_FF * 2);
static_assert(O_F + (size_t)FCH * D_MODEL * 4 <= O_MASK, "ffn chunk fits");
constexpr size_t WS_NEED = T1_END;
static_assert(WS_NEED <= (size_t)352 * 1024 * 1024, "workspace budget");


#define LAS __attribute__((address_space(3)))
#define XB_TMO      128
#define XB_XCNT(j)  (256  + 64 * (j))
#define XB_XSUB(j)  (1280 + 64 * (j))
#define XB_XGEN(j)  (2304 + 64 * (j))
#define XB_TOP      3328
#define XB_TOPGEN   3392
#define XCD_BAR_WORDS 3456
#define XB_SPIN_CAP (1u << 22)
__device__ __forceinline__ unsigned xb_ld(unsigned* p)              { return __hip_atomic_load(p, __ATOMIC_RELAXED, __HIP_MEMORY_SCOPE_AGENT); }
__device__ __forceinline__ unsigned xb_add(unsigned* p, unsigned v) { return __hip_atomic_fetch_add(p, v, __ATOMIC_RELAXED, __HIP_MEMORY_SCOPE_AGENT); }
__device__ __forceinline__ unsigned xb_xcc_id() { return (unsigned)__builtin_amdgcn_s_getreg((3 << 11) | 20) & 0xFu; }
#define XB_SPIN(cond, bar) do { unsigned _sp = 0; while (cond) { __builtin_amdgcn_s_sleep(1); \
    if ((++_sp & 255u) == 0u) { if (xb_ld(&(bar)[XB_TMO])) break; if (_sp > XB_SPIN_CAP) { atomicAdd(&(bar)[XB_TMO], 1u); break; } } } } while (0)
struct XcdBarrier { unsigned* bar; unsigned x; volatile LAS unsigned* st; };
__device__ __forceinline__ XcdBarrier xcd_barrier_post(unsigned* bar, volatile LAS unsigned* st) {
    XcdBarrier b; b.bar = bar; b.x = xb_xcc_id(); b.st = st;
    if (threadIdx.x == 0) (void)xb_add(&bar[XB_XCNT(b.x)], 1u);
    return b;
}
__device__ __forceinline__ void xcd_barrier_complete(unsigned* bar, unsigned x, unsigned& nloc, unsigned& nx) {
    const unsigned G = gridDim.x * gridDim.y * gridDim.z;
    unsigned sum, cnt, mine, sp = 0u;
    for (;;) {
        sum = 0u; cnt = 0u; mine = 0u;
#pragma unroll
        for (unsigned j = 0; j < 16; ++j) { const unsigned c = xb_ld(&bar[XB_XCNT(j)]); sum += c; cnt += (c > 0u) ? 1u : 0u; mine = (j == x) ? c : mine; }
        if (sum == G) break;
        __builtin_amdgcn_s_sleep(1);
        if ((++sp & 255u) == 0u) { if (xb_ld(&bar[XB_TMO])) break; if (sp > XB_SPIN_CAP) { atomicAdd(&bar[XB_TMO], 1u); break; } }
    }
    nloc = mine > 0u ? mine : 1u; nx = cnt > 0u ? cnt : 1u;
}
__device__ __forceinline__ void xcd_barrier(const XcdBarrier& b) {
    asm volatile("s_waitcnt vmcnt(0)" ::: "memory");
    __syncthreads();
    if (threadIdx.x == 0) {
        unsigned* bar = b.bar;
        __builtin_amdgcn_s_waitcnt(0);
        unsigned nloc = b.st[0], nx = b.st[1];
        if (nloc == 0u) { xcd_barrier_complete(bar, b.x, nloc, nx); b.st[0] = nloc; b.st[1] = nx; }
        const unsigned old = xb_add(&bar[XB_XSUB(b.x)], 1u);
        const unsigned gen = old / nloc;
        if (old + 1u == (gen + 1u) * nloc) {
            __builtin_amdgcn_fence(__ATOMIC_RELEASE, "agent");
            asm volatile("s_waitcnt vmcnt(0)" ::: "memory");
            const unsigned og = xb_add(&bar[XB_TOP], 1u);
            const unsigned tg = og / nx;
            if (og + 1u == (tg + 1u) * nx) xb_add(&bar[XB_TOPGEN], 1u);
            else XB_SPIN(xb_ld(&bar[XB_TOPGEN]) == tg, bar);
            __builtin_amdgcn_fence(__ATOMIC_ACQUIRE, "agent");
            xb_add(&bar[XB_XGEN(b.x)], 1u);
            asm volatile("s_waitcnt vmcnt(0)" ::: "memory");
        } else {
            XB_SPIN(xb_ld(&bar[XB_XGEN(b.x)]) == gen, bar);
            __builtin_amdgcn_fence(__ATOMIC_ACQUIRE, "agent");
            asm volatile("s_waitcnt vmcnt(0)" ::: "memory");
        }
    }
    __syncthreads();
}

constexpr size_t O_CTL = (WS_NEED + 4095) & ~(size_t)4095;
constexpr size_t CTL_BYTES = 65536;
static_assert(O_CTL + CTL_BYTES <= (size_t)352 * 1024 * 1024, "workspace budget");

struct Args { const float* in[18]; float* out; char* ws; };

template <class Epi> __device__ __forceinline__ void gemm_stage(const bf16_t* A, const bf16_t* Bt, int M, int N, int K, int lda, int ldb, size_t zA, size_t zB, int nz, const Epi& e) {
    GemmP g{A, Bt, zA, zB, M, N, K, lda, ldb, 0};
    const int nx = (N + 127) / 128, ny = (M + 127) / 128, nvb = nx * ny * nz;
    for (int vb = blockIdx.x; vb < nvb; vb += gridDim.x) k_gemm(g, e, vb % nx, (vb / nx) % ny, vb / (nx * ny));
}

__global__ __launch_bounds__(256) void mega_v2(Args a) {
    __shared__ unsigned bst[4];
    if (threadIdx.x < 4) bst[threadIdx.x] = 0u;
    __syncthreads();
    const float* x = a.in[0]; const float* meta = a.in[1]; const float* relb = a.in[2]; const float* w_in = a.in[3];
    const float* kvg = a.in[4]; const float* w_uk = a.in[5]; const float* w_uv = a.in[6]; const float* w_pool = a.in[7];
    const float* pscale = a.in[8]; const float* w_o = a.in[9]; const float* ln1g = a.in[10]; const float* ln1b = a.in[11];
    const float* w_up = a.in[12]; const float* convw = a.in[13]; const float* convb = a.in[14]; const float* w_dn = a.in[15];
    const float* ln2g = a.in[16]; const float* ln2b = a.in[17];
    char* ws = a.ws; float* out = a.out;
    bf16_t *WinT = (bf16_t*)(ws + O_WIN), *WoT = (bf16_t*)(ws + O_WO), *WupT = (bf16_t*)(ws + O_WUP), *WdnT = (bf16_t*)(ws + O_WDN), *wukb = (bf16_t*)(ws + O_WUK), *wuvT = (bf16_t*)(ws + O_WUVT), *wpT = (bf16_t*)(ws + O_WPT);
    bf16_t *hb = (bf16_t*)(ws + O_HB), *q = (bf16_t*)(ws + O_Q), *qidx = (bf16_t*)(ws + O_QIDX), *kidx = (bf16_t*)(ws + O_KIDX), *ckv = (bf16_t*)(ws + O_CKV), *qabs = (bf16_t*)(ws + O_QABS);
    float *ckvraw = (float*)(ws + O_CKVRAW), *widx = (float*)(ws + O_WIDX), *u = (float*)(ws + O_U), *sc = (float*)(ws + O_SC), *mix = (float*)(ws + O_MIX), *h1 = (float*)(ws + O_H1);
    unsigned* mask = (unsigned*)(ws + O_MASK);
    bf16_t *olat = (bf16_t*)(ws + O_OLAT), *diff = (bf16_t*)(ws + O_DIFF), *cat = (bf16_t*)(ws + O_CAT), *h1f = (bf16_t*)(ws + O_H1F), *act = (bf16_t*)(ws + O_ACT);
    float *zc = (float*)(ws + O_Z), *fc = (float*)(ws + O_F);
    XcdBarrier bar = xcd_barrier_post((unsigned*)(ws + O_CTL), (volatile LAS unsigned*)bst);
    const int G = gridDim.x, B0 = blockIdx.x;
#define TRANSPOSE_STAGE(W, WT, K, N, NP) do { const int nx_ = (NP) / 32, ny_ = (K) / 32; for (int vb = B0; vb < nx_ * ny_; vb += G) k_transpose(W, WT, K, N, NP, vb % nx_, vb / nx_); } while (0)
    k_rows_bf16(x, meta, hb);
    TRANSPOSE_STAGE(w_in, WinT, D_MODEL, PROJ, PROJ_PAD);
    TRANSPOSE_STAGE(w_o, WoT, D_MODEL, D_MODEL, D_MODEL);
    TRANSPOSE_STAGE(w_up, WupT, D_MODEL, 2 * D_FF, 2 * D_FF);
    TRANSPOSE_STAGE(w_dn, WdnT, D_FF, D_MODEL, D_MODEL);
    k_cvt(w_uk, wukb, (size_t)CKV * 1024);
    TRANSPOSE_STAGE(w_uv, wuvT, CKV, 1024, 1024);
    for (int g = 0; g < 4; ++g) TRANSPOSE_STAGE(w_pool + (size_t)g * PG * PG, wpT + (size_t)g * PG * PG, PG, PG, PG);
    xcd_barrier(bar);
    gemm_stage(hb, WinT, R, PROJ_PAD, D_MODEL, D_MODEL, D_MODEL, 0, 0, 1, EpiProj{q, ckvraw, qidx, kidx, widx, u});
    xcd_barrier(bar);
    for (int vb = B0; vb < (R + 3) / 4; vb += G) k_rmsnorm(ckvraw, kvg, ckv, vb);
    gemm_stage(q, wukb, R, CKV, HD, 1024, 1024, (size_t)HD, (size_t)HD, NH, EpiBf16Z{qabs, nullptr, (size_t)CKV, NH * CKV, 0});
    for (int vb = B0; vb < T * BATCH; vb += G) k_scores(qidx, kidx, widx, sc, vb % T, vb / T);
    xcd_barrier(bar);
    for (int vb = B0; vb < (BATCH * T + 3) / 4; vb += G) k_topk(sc, mask, vb);
    xcd_barrier(bar);
    for (int vb = B0; vb < T * BATCH; vb += G) k_pooldiff(u, diff, vb % T, vb / T);
    for (int vb = B0; vb < T * BATCH; vb += G) k_attn(qabs, ckv, mask, relb, olat, vb % T, vb / T);
    xcd_barrier(bar);
    gemm_stage(diff, wpT, R, PG, PG, POOLW, PG, (size_t)PG, (size_t)PG * PG, 4, EpiBf16Z{cat + 1024, pscale, (size_t)PG, D_MODEL, PG});
    gemm_stage(olat, wuvT, R, HD, CKV, NH * CKV, CKV, (size_t)CKV, (size_t)HD * CKV, NH, EpiBf16Z{cat, nullptr, (size_t)HD, D_MODEL, 0});
    xcd_barrier(bar);
    gemm_stage(cat, WoT, R, D_MODEL, D_MODEL, D_MODEL, D_MODEL, 0, 0, 1, EpiF32{mix, D_MODEL, 0});
    xcd_barrier(bar);
    for (int vb = B0; vb < R; vb += G) k_ln1(x, meta, mix, ln1g, ln1b, h1, h1f, vb);
    xcd_barrier(bar);
    for (int b = 0; b < BATCH; ++b)
        for (int c0 = 0; c0 < SEQ; c0 += FCH) {
            const bf16_t* Ain = h1f + ((size_t)b * 2050 + c0) * D_MODEL;
            gemm_stage(Ain, WupT, FCH + 2, 2 * D_FF, D_MODEL, D_MODEL, D_MODEL, 0, 0, 1, EpiF32{zc, 2 * D_FF, 0});
            xcd_barrier(bar);
            for (int vb = B0; vb < FCH; vb += G) k_convglu(zc, convw, convb, act, vb);
            xcd_barrier(bar);
            gemm_stage(act, WdnT, FCH, D_MODEL, D_FF, D_FF, D_FF, 0, 0, 1, EpiF32{fc, D_MODEL, 0});
            xcd_barrier(bar);
            const size_t r0 = (size_t)b * SEQ + c0;
            for (int vb = B0; vb < FCH; vb += G) k_ln2(h1 + r0 * D_MODEL, fc, ln2g, ln2b, out + r0 * D_MODEL, vb);
        }
}

extern "C" void kernel_launch(void* const* d_in, const int* in_sizes, int n_in, void* d_out, int out_size, void* d_ws, size_t ws_size, hipStream_t stream) {
    static int grid = 0;
    if (grid == 0) {
        if (ws_size < O_CTL + CTL_BYTES || n_in != 18) { fprintf(stderr, "kernel_launch: bad workspace/inputs: ws %zu need %zu n_in %d\n", ws_size, (size_t)(O_CTL + CTL_BYTES), n_in); grid = -1; return; }
        int dev = 0, cus = 0, per_cu = 0;
        (void)hipGetDevice(&dev); (void)hipDeviceGetAttribute(&cus, hipDeviceAttributeMultiprocessorCount, dev);
        (void)hipOccupancyMaxActiveBlocksPerMultiprocessor(&per_cu, (const void*)mega_v2, 256, 0);
        if (per_cu < 1) per_cu = 1;
        if (per_cu > 2) per_cu = 2;
        grid = cus * per_cu;
    }
    if (grid < 0) return;
    (void)hipMemsetAsync((char*)d_ws + O_CTL, 0, CTL_BYTES, stream);
    Args a{};
    for (int i = 0; i < 18; ++i) a.in[i] = (const float*)d_in[i];
    a.out = (float*)d_out; a.ws = (char*)d_ws;
    hipLaunchKernelGGL(mega_v2, dim3(grid), dim3(256), 0, stream, a);
}
```

```cpp
#include <hip/hip_runtime.h>
#include <cstdint>
#include <cstdio>

typedef unsigned short bf16_t;
typedef short bf16x8 __attribute__((ext_vector_type(8)));
typedef float f32x4 __attribute__((ext_vector_type(4)));
typedef float f32x2 __attribute__((ext_vector_type(2)));
typedef float f32x16 __attribute__((ext_vector_type(16)));
typedef unsigned u32x4 __attribute__((ext_vector_type(4)));
typedef unsigned u32x2 __attribute__((ext_vector_type(2)));
#define LAS __attribute__((address_space(3)))
#define GAS __attribute__((address_space(1)))

constexpr int D_MODEL = 2048, BATCH = 4, SEQ = 2048, N_META = 16, T = SEQ + N_META;
constexpr int NH = 8, HD = 128, CKV = 256, IH = 16, IDIM = 64, TOPK = 256;
constexpr int POOLW = 1024, PG = 256, D_FF = 5632;
constexpr int PROJ = 3408, PROJ_PAD = 3584;
constexpr int R = BATCH * SEQ + N_META;
constexpr int RREAL = BATCH * SEQ;
constexpr int RP = 8448;
constexpr float ALPHA = 1.189207115002721f;
constexpr float LN_EPS = 1e-5f;
constexpr int MW = 68;
constexpr int SCP = 2080;

__host__ __device__ __forceinline__ int rid(int b, int t) { return t < N_META ? RREAL + t : b * SEQ + (t - N_META); }
__device__ __forceinline__ unsigned f2bf(float f) { unsigned u = __builtin_bit_cast(unsigned, f); return (u + 0x7fffu + ((u >> 16) & 1u)) >> 16; }
__device__ __forceinline__ unsigned pk2(float lo, float hi) { return f2bf(lo) | (f2bf(hi) << 16); }
__device__ __forceinline__ float bf2f(bf16_t h) { return __builtin_bit_cast(float, (unsigned)h << 16); }
__device__ __forceinline__ float bflo(unsigned w) { return __builtin_bit_cast(float, w << 16); }
__device__ __forceinline__ float bfhi(unsigned w) { return __builtin_bit_cast(float, w & 0xffff0000u); }

__device__ const unsigned char T5_BUCKET[128] = {
    0, 1, 2, 3, 4, 5, 6, 7, 8, 9, 10, 11, 12, 13, 14, 15, 16, 16, 16, 17, 17, 18, 18, 18, 19, 19, 19, 20, 20, 20, 20, 21, 21, 21, 21, 22, 22, 22, 22, 22,
    23, 23, 23, 23, 23, 23, 24, 24, 24, 24, 24, 24, 25, 25, 25, 25, 25, 25, 25, 26, 26, 26, 26, 26, 26, 26, 26, 27, 27, 27, 27, 27, 27, 27, 27, 27, 27,
    28, 28, 28, 28, 28, 28, 28, 28, 28, 28, 29, 29, 29, 29, 29, 29, 29, 29, 29, 29, 29, 29, 30, 30, 30, 30, 30, 30, 30, 30, 30, 30, 30, 30, 30, 30,
    31, 31, 31, 31, 31, 31, 31, 31, 31, 31, 31, 31, 31, 31, 31};

namespace pg8 {
constexpr int BM = 256, BK = 64, HALF = 128, HTB = HALF * BK * 2  , STAGE_BYTES = 8 * HTB, NXCD = 8, WGM = 8;
__host__ __device__ __forceinline__ int lds_byte(int r, int c) { const int st = (r >> 4) * 2 + (c >> 5), rr = r & 15, cc = c & 31, ob = rr * 64 + cc * 2; return st * 1024 + (ob ^ (((ob >> 9) & 1) << 5)); }
__host__ __device__ __forceinline__ void stage_rc(int b, int& R_, int& C) { const int st = b / 1024, sb = b % 1024, swz = sb ^ (((sb >> 9) & 1) << 5); R_ = (st >> 1) * 16 + swz / 64; C = (st & 1) * 32 + (swz % 64) / 2; }
__host__ __device__ __forceinline__ int perm32(int rho) { const int n = rho >> 4, i = rho & 15; return 8 * (i >> 2) + 4 * n + (i & 3); }
struct Unit { int pm, pn; };
struct Gemm { const bf16_t* A; const bf16_t* Bt; };

struct StaticOrder {
    int nM, nN, nwg, G, c;
    __host__ __device__ void init(int M, int N, int G_, int c_) { nM = M / BM; nN = N / BM; nwg = nM * nN; G = G_; c = c_; }
    __host__ __device__ bool next(int i, Unit& u) const {
        const long L = (long)i * G + c; if (L >= nwg) return false;
        int wgid = (int)L; { const int q = nwg / NXCD, r = nwg % NXCD, xcd = wgid % NXCD, off = wgid / NXCD; wgid = (xcd < r ? xcd * (q + 1) : r * (q + 1) + (xcd - r) * q) + off; }
        const int nig = WGM * nN, gid = wgid / nig, fm = gid * WGM, gsz = (nM - fm) < WGM ? (nM - fm) : WGM;
        u.pm = fm + ((wgid % nig) % gsz); u.pn = (wgid % nig) / gsz; return true;
    }
};
struct OneUnit { Unit u; __device__ bool next(int i, Unit& o) const { if (i > 0) return false; o = u; return true; } };

template <class Epi, class Sched, bool ALIGN_EPI, bool SP2, int K, int LDA, int LDB>
__device__ __forceinline__ void gemm_phase(LAS unsigned char* lds, const Gemm g, const Sched& S, const Epi& E) {
    int tid = threadIdx.x; asm volatile("" : "+v"(tid));
    const int wid = __builtin_amdgcn_readfirstlane(tid >> 6), lane = tid & 63, wr = wid >> 2, wc = wid & 3, fr = lane & 15, fq = lane >> 4;
    constexpr int nt = K / BK;
    unsigned voffA[2], voffB[2];
#pragma unroll
    for (int i = 0; i < 2; ++i) { int R_, C; stage_rc(tid * 16 + i * 8192, R_, C); const int Rb = Epi::PERM ? ((R_ & ~31) + perm32(R_ & 31)) : R_;
        voffA[i] = (unsigned)(R_ * LDA + C) * 2u; voffB[i] = (unsigned)(Rb * LDB + C) * 2u; }
    constexpr size_t kstep = (size_t)(BK * 2);
    constexpr size_t hstepA = (size_t)HALF * LDA * 2, hstepB = (size_t)HALF * LDB * 2;
    constexpr size_t tstepA = 2 * hstepA, tstepB = 2 * hstepB;
    const unsigned ldsw = (unsigned)wid * 1024u;
    const int aoff = lds_byte(wr * 64 + fr, fq * 8), boff = lds_byte(wc * 32 + fr, fq * 8);
#define PG8_SA(b, h) (((b) * 2 + (h)) * HTB)
#define PG8_SB(b, h) ((4 + (b) * 2 + (h)) * HTB)
#define PG8_STAGE(bufoff, gbase, voff) do { _Pragma("unroll") for (int _i = 0; _i < 2; ++_i) \
        __builtin_amdgcn_global_load_lds((const unsigned*)((const char*)(gbase) + (voff)[_i]), (LAS unsigned*)(lds + (bufoff) + ldsw + _i * 8192), 16, 0, 0); } while (0)
#define PG8_LDA(dst, b, h) do { _Pragma("unroll") for (int m = 0; m < 4; ++m) _Pragma("unroll") for (int k = 0; k < 2; ++k) dst[m][k] = *(const LAS bf16x8*)(lds + PG8_SA(b, h) + aoff + m * 2048 + k * 1024); } while (0)
#define PG8_LDB(dst, b, h) do { _Pragma("unroll") for (int n = 0; n < 2; ++n) _Pragma("unroll") for (int k = 0; k < 2; ++k) dst[n][k] = *(const LAS bf16x8*)(lds + PG8_SB(b, h) + boff + n * 2048 + k * 1024); } while (0)
#define PG8_MMA(ai, bj, At, Bt) do { __builtin_amdgcn_s_setprio(1); _Pragma("unroll") for (int m = 0; m < 4; ++m) _Pragma("unroll") for (int n = 0; n < 2; ++n) _Pragma("unroll") for (int k = 0; k < 2; ++k) \
        acc[ai][bj][m][n] = __builtin_amdgcn_mfma_f32_16x16x32_bf16(Bt[n][k], At[m][k], acc[ai][bj][m][n], 0, 0, 0); __builtin_amdgcn_s_setprio(0); } while (0)
#define PG8_WAIT_V(n) asm volatile("s_waitcnt vmcnt(" #n ")" ::: "memory")
#define PG8_WAIT_L(n) asm volatile("s_waitcnt lgkmcnt(" #n ")" ::: "memory")
#define PG8_BAR __builtin_amdgcn_s_barrier()
#define PG8_SCHED __builtin_amdgcn_sched_barrier(0)
    Unit cur, nxt; int ui = 0;
    if (!S.next(0, cur)) return;
    f32x4 acc[2][2][4][2];
#pragma unroll
    for (int a = 0; a < 2; ++a)
#pragma unroll
        for (int b = 0; b < 2; ++b)
#pragma unroll
            for (int m = 0; m < 4; ++m)
#pragma unroll
                for (int n = 0; n < 2; ++n) acc[a][b][m][n] = (f32x4){0.f, 0.f, 0.f, 0.f};
    bf16x8 At[4][2], B0[2][2], B1[2][2];
    const char* cA = (const char*)g.A + (size_t)cur.pm * tstepA; const char* cB = (const char*)g.Bt + (size_t)cur.pn * tstepB;
    if constexpr (SP2) {
        PG8_STAGE(PG8_SB(0, 0), cB, voffB); PG8_STAGE(PG8_SB(0, 1), cB + hstepB, voffB); PG8_STAGE(PG8_SA(0, 0), cA, voffA); PG8_STAGE(PG8_SA(0, 1), cA + hstepA, voffA);
        if (wr == 1) PG8_BAR;
        PG8_WAIT_V(2); PG8_BAR;
        PG8_STAGE(PG8_SB(1, 0), cB + kstep, voffB); PG8_STAGE(PG8_SA(1, 0), cA + kstep, voffA); PG8_STAGE(PG8_SB(1, 1), cB + hstepB + kstep, voffB);
        PG8_WAIT_V(6); PG8_BAR;
    } else {
        PG8_STAGE(PG8_SB(0, 0), cB, voffB); PG8_STAGE(PG8_SA(0, 0), cA, voffA); PG8_STAGE(PG8_SB(0, 1), cB + hstepB, voffB); PG8_STAGE(PG8_SA(0, 1), cA + hstepA, voffA);
        if (wr == 1) PG8_BAR;
        PG8_WAIT_V(4); PG8_BAR;
        PG8_STAGE(PG8_SB(1, 0), cB + kstep, voffB); PG8_STAGE(PG8_SA(1, 0), cA + kstep, voffA); PG8_STAGE(PG8_SB(1, 1), cB + hstepB + kstep, voffB);
        PG8_WAIT_V(6); PG8_BAR;
    }
    for (;;) {
        const bool has_next = S.next(ui + 1, nxt);
        const char* nA = has_next ? (const char*)g.A + (size_t)nxt.pm * tstepA : cA; const char* nB = has_next ? (const char*)g.Bt + (size_t)nxt.pn * tstepB : cB;
        for (int t = 0; t < nt; t += 2) {
            const bool last = (t == nt - 2);
            const char* a1 = cA + (size_t)(t + 1) * kstep;
            const char* a2 = last ? nA : cA + (size_t)(t + 2) * kstep; const char* b2 = last ? nB : cB + (size_t)(t + 2) * kstep;
            const char* a3 = a2 + kstep; const char* b3 = b2 + kstep;
            if constexpr (SP2) {
            PG8_LDB(B0, 0, 0); PG8_LDB(B1, 0, 1); PG8_SCHED; PG8_LDA(At, 0, 0); PG8_STAGE(PG8_SA(1, 1), a1 + hstepA, voffA);
            PG8_WAIT_V(8); PG8_WAIT_L(0); PG8_BAR; PG8_MMA(0, 0, At, B0); PG8_MMA(0, 1, At, B1); PG8_BAR; PG8_SCHED;
            PG8_LDA(At, 0, 1); PG8_STAGE(PG8_SB(0, 0), b2, voffB); PG8_STAGE(PG8_SB(0, 1), b2 + hstepB, voffB); PG8_STAGE(PG8_SA(0, 0), a2, voffA);
            PG8_WAIT_V(8); PG8_WAIT_L(0); PG8_BAR; PG8_MMA(1, 0, At, B0); PG8_MMA(1, 1, At, B1); PG8_BAR; PG8_SCHED;
            PG8_LDB(B0, 1, 0); PG8_LDB(B1, 1, 1); PG8_SCHED; PG8_LDA(At, 1, 0); PG8_STAGE(PG8_SA(0, 1), a2 + hstepA, voffA);
            PG8_WAIT_V(8); PG8_WAIT_L(0); PG8_BAR; PG8_MMA(0, 0, At, B0); PG8_MMA(0, 1, At, B1); PG8_BAR; PG8_SCHED;
            PG8_LDA(At, 1, 1); PG8_STAGE(PG8_SB(1, 0), b3, voffB); PG8_STAGE(PG8_SB(1, 1), b3 + hstepB, voffB); PG8_STAGE(PG8_SA(1, 0), a3, voffA);
            PG8_WAIT_V(8); PG8_WAIT_L(0); PG8_BAR; PG8_MMA(1, 0, At, B0); PG8_MMA(1, 1, At, B1); PG8_BAR; PG8_SCHED;
            } else {
            PG8_LDB(B0, 0, 0); PG8_SCHED; PG8_LDA(At, 0, 0); PG8_STAGE(PG8_SA(1, 1), a1 + hstepA, voffA);
            PG8_WAIT_L(8); PG8_BAR; PG8_WAIT_L(0); PG8_MMA(0, 0, At, B0); PG8_BAR; PG8_SCHED;
            PG8_LDB(B1, 0, 1); PG8_STAGE(PG8_SB(0, 0), b2, voffB);
            PG8_BAR; PG8_WAIT_L(0); PG8_MMA(0, 1, At, B1); PG8_BAR;
            PG8_LDA(At, 0, 1); PG8_STAGE(PG8_SA(0, 0), a2, voffA);
            PG8_BAR; PG8_WAIT_L(0); PG8_MMA(1, 0, At, B0); PG8_BAR; PG8_SCHED;
            PG8_STAGE(PG8_SB(0, 1), b2 + hstepB, voffB);
            PG8_WAIT_V(6); PG8_BAR; PG8_MMA(1, 1, At, B1); PG8_BAR;
            PG8_LDB(B0, 1, 0); PG8_SCHED; PG8_LDA(At, 1, 0); PG8_STAGE(PG8_SA(0, 1), a2 + hstepA, voffA);
            PG8_WAIT_L(8); PG8_BAR; PG8_WAIT_L(0); PG8_MMA(0, 0, At, B0); PG8_BAR; PG8_SCHED;
            PG8_LDB(B1, 1, 1); PG8_STAGE(PG8_SB(1, 0), b3, voffB);
            PG8_BAR; PG8_WAIT_L(0); PG8_MMA(0, 1, At, B1); PG8_BAR;
            PG8_LDA(At, 1, 1); PG8_STAGE(PG8_SA(1, 0), a3, voffA);
            PG8_BAR; PG8_WAIT_L(0); PG8_MMA(1, 0, At, B0); PG8_BAR; PG8_SCHED;
            PG8_STAGE(PG8_SB(1, 1), b3 + hstepB, voffB);
            PG8_WAIT_V(6); PG8_BAR; PG8_MMA(1, 1, At, B1); PG8_BAR;
            }
        }
        if constexpr (ALIGN_EPI) { if (wr == 0) PG8_BAR; }
        if constexpr (!Epi::AFTER_DRAIN) { E(acc, cur, wr, wc, fr, fq, lds, wid, lane); }
        if (!has_next) break;
#pragma unroll
        for (int a = 0; a < 2; ++a)
#pragma unroll
            for (int b = 0; b < 2; ++b)
#pragma unroll
                for (int m = 0; m < 4; ++m)
#pragma unroll
                    for (int n = 0; n < 2; ++n) acc[a][b][m][n] = (f32x4){0.f, 0.f, 0.f, 0.f};
        cur = nxt; cA = nA; cB = nB; ++ui;
        if constexpr (ALIGN_EPI) { if (wr == 1) PG8_BAR; }
    }
    PG8_WAIT_V(0);
    if constexpr (!ALIGN_EPI) { if (wr == 0) PG8_BAR; }
    PG8_BAR;
    if constexpr (Epi::AFTER_DRAIN) { E.fused(acc, cur, wr, wc, fr, fq, lds, wid, lane); }
#undef PG8_SA
#undef PG8_SB
#undef PG8_STAGE
#undef PG8_LDA
#undef PG8_LDB
#undef PG8_MMA
#undef PG8_WAIT_V
#undef PG8_WAIT_L
#undef PG8_BAR
#undef PG8_SCHED
}
}
typedef __bf16 bf16x2_t __attribute__((ext_vector_type(2)));
__device__ __forceinline__ unsigned cvtpk(float lo, float hi) { f32x2 v = {lo, hi}; bf16x2_t b = __builtin_convertvector(v, bf16x2_t); return __builtin_bit_cast(unsigned, b); }
__device__ __forceinline__ u32x4 pack8(const f32x4 a, const f32x4 b) { u32x4 w; w.x = cvtpk(a[0], a[1]); w.y = cvtpk(a[2], a[3]); w.z = cvtpk(b[0], b[1]); w.w = cvtpk(b[2], b[3]); return w; }
constexpr int XOFF = pg8::STAGE_BYTES;

struct EpiProj {
    static constexpr bool PERM = true, AFTER_DRAIN = false;
    bf16_t* q; float* ckvraw; bf16_t* qidx; bf16_t* u; bf16_t* kidx; float* widx;
    __device__ __forceinline__ void operator()(const f32x4 (&acc)[2][2][4][2], const pg8::Unit& un, int wr, int wc, int fr, int fq, LAS unsigned char*, int, int) const {
        const int pn = un.pn, row0 = un.pm * 256 + wr * 64 + fr;
#pragma unroll
        for (int ai = 0; ai < 2; ++ai)
#pragma unroll
            for (int m = 0; m < 4; ++m) { const size_t r = (size_t)(row0 + ai * 128 + m * 16);
#pragma unroll
                for (int bj = 0; bj < 2; ++bj) { const int c = bj * 128 + wc * 32 + 8 * fq; const f32x4 v0 = acc[ai][bj][m][0], v1 = acc[ai][bj][m][1];
                    if (pn < 4) *(u32x4*)(q + r * 1024 + pn * 256 + c) = pack8(v0, v1);
                    else if (pn == 4) { *(f32x4*)(ckvraw + r * CKV + c) = v0; *(f32x4*)(ckvraw + r * CKV + c + 4) = v1; }
                    else if (pn < 9) *(u32x4*)(qidx + r * 1024 + (pn - 5) * 256 + c) = pack8(v0 * 0.125f, v1 * 0.125f);
                    else if (pn < 13) *(u32x4*)(u + r * 1024 + (pn - 9) * 256 + c) = pack8(v0, v1);
                    else { if (c < 64) *(u32x4*)(kidx + r * IDIM + c) = pack8(v0, v1);
                           else if (c < 80) { *(f32x4*)(widx + r * IH + (c - 64)) = v0 * 0.25f; *(f32x4*)(widx + r * IH + (c - 64) + 4) = v1 * 0.25f; } } } }
    }
};
struct EpiBf16P {
    static constexpr bool PERM = true, AFTER_DRAIN = false;
    bf16_t* C; int ldc;
    __device__ __forceinline__ void operator()(const f32x4 (&acc)[2][2][4][2], const pg8::Unit& un, int wr, int wc, int fr, int fq, LAS unsigned char*, int, int) const {
        const int row0 = un.pm * 256 + wr * 64 + fr;
#pragma unroll
        for (int ai = 0; ai < 2; ++ai)
#pragma unroll
            for (int m = 0; m < 4; ++m) { const size_t r = (size_t)(row0 + ai * 128 + m * 16);
#pragma unroll
                for (int bj = 0; bj < 2; ++bj) { const int c = un.pn * 256 + bj * 128 + wc * 32 + 8 * fq;
                    *(u32x4*)(C + r * ldc + c) = pack8(acc[ai][bj][m][0], acc[ai][bj][m][1]); } }
    }
};
struct EpiPre {
    static constexpr bool PERM = false, AFTER_DRAIN = false;
    const float* base; float* out; int ldc;
    __device__ __forceinline__ void operator()(const f32x4 (&acc)[2][2][4][2], const pg8::Unit& un, int wr, int wc, int fr, int fq, LAS unsigned char*, int, int) const {
        const int row0 = un.pm * 256 + wr * 64 + fr, col0 = un.pn * 256 + wc * 32 + 4 * fq;
#pragma unroll
        for (int ai = 0; ai < 2; ++ai)
#pragma unroll
            for (int m = 0; m < 4; ++m) { const size_t off = (size_t)(row0 + ai * 128 + m * 16) * ldc + col0;
#pragma unroll
                for (int bj = 0; bj < 2; ++bj)
#pragma unroll
                    for (int n = 0; n < 2; ++n) { const f32x4 bs = *(const f32x4*)(base + off + bj * 128 + n * 16); *(f32x4*)(out + off + bj * 128 + n * 16) = bs * ALPHA + acc[ai][bj][m][n]; } }
    }
};
__device__ __forceinline__ float gelu_tanh(float x) {
    const float t = x * x * 0.044715f + 1.0f; const float e = __builtin_amdgcn_exp2f(-2.302208198f * x * t); return x * __builtin_amdgcn_rcpf(1.0f + e); }
template <int CTRL> __device__ __forceinline__ float dpp0(float v) { return __builtin_bit_cast(float, __builtin_amdgcn_update_dpp(0, __builtin_bit_cast(int, v), CTRL, 0xf, 0xf, true)); }
__device__ __forceinline__ f32x4 shfl4(const f32x4 v, int src) { f32x4 r; r[0] = __shfl(v[0], src); r[1] = __shfl(v[1], src); r[2] = __shfl(v[2], src); r[3] = __shfl(v[3], src); return r; }
struct EpiConv {
    static constexpr bool PERM = true, AFTER_DRAIN = false;
    bf16_t* act; float* head; float* tail; const float* cw; const float* cb;
    __device__ __forceinline__ void operator()(const f32x4 (&acc)[2][2][4][2], const pg8::Unit& un, int wr, int wc, int fr, int fq, LAS unsigned char* lds, int, int lane) const {
        LAS float* X = (LAS float*)(lds + XOFF);
        const int colb = wc * 32 + 8 * fq, pm = un.pm, pn = un.pn;
        if (wr == 0 && fr < 2) {
#pragma unroll
            for (int bj = 0; bj < 2; ++bj)
#pragma unroll
                for (int n = 0; n < 2; ++n) *(f32x4*)(head + ((size_t)pm * 2 + fr) * (2 * D_FF) + pn * 256 + bj * 128 + colb + 4 * n) = acc[0][bj][0][n]; }
        if (wr == 1 && fr >= 14) {
#pragma unroll
            for (int bj = 0; bj < 2; ++bj)
#pragma unroll
                for (int n = 0; n < 2; ++n) *(f32x4*)(tail + ((size_t)pm * 2 + (fr - 14)) * (2 * D_FF) + pn * 256 + bj * 128 + colb + 4 * n) = acc[1][bj][3][n]; }
        if (fr >= 14) {
#pragma unroll
            for (int ai = 0; ai < 2; ++ai)
#pragma unroll
                for (int bj = 0; bj < 2; ++bj)
#pragma unroll
                    for (int n = 0; n < 2; ++n) *(LAS f32x4*)(X + ((2 * ai + wr) * 2 + (fr - 14)) * 256 + bj * 128 + colb + 4 * n) = acc[ai][bj][3][n]; }
        asm volatile("s_waitcnt lgkmcnt(0)" ::: "memory"); __builtin_amdgcn_s_barrier(); asm volatile("" ::: "memory");
        const int colA = pn * 128 + colb;
        u32x2 stash[2][4];
#pragma unroll
        for (int n = 0; n < 2; ++n) {
            f32x4 w[2][3], bb[2];
#pragma unroll
            for (int p = 0; p < 2; ++p) { bb[p] = *(const f32x4*)(cb + p * D_FF + colA + 4 * n);
#pragma unroll
                for (int j = 0; j < 3; ++j) w[p][j] = *(const f32x4*)(cw + (size_t)j * (2 * D_FF) + p * D_FF + colA + 4 * n); }
#pragma unroll
            for (int ai = 0; ai < 2; ++ai)
#pragma unroll
                for (int m = 0; m < 4; ++m) {
                    const int chunk = 2 * ai + wr;
                    f32x4 cv[2];
#pragma unroll
                    for (int p = 0; p < 2; ++p) {
                        const f32x4 cur = acc[ai][p][m][n];
                        f32x4 o = cur * w[p][2] + bb[p];
#pragma unroll
                        for (int e = 0; e < 4; ++e) { o[e] = fmaf(dpp0<0x111>(cur[e]), w[p][1][e], o[e]); o[e] = fmaf(dpp0<0x112>(cur[e]), w[p][0][e], o[e]); }
                        if (m > 0) { const f32x4 pg = acc[ai][p][m - 1][n];
#pragma unroll
                            for (int e = 0; e < 4; ++e) { o[e] = fmaf(dpp0<0x10F>(pg[e]), w[p][1][e], o[e]); o[e] = fmaf(dpp0<0x10E>(pg[e]), w[p][0][e], o[e]); } }
                        else { const int pc = chunk > 0 ? chunk - 1 : 0;
                            f32x4 x1 = *(const LAS f32x4*)(X + (pc * 2 + 1) * 256 + p * 128 + colb + 4 * n);
                            f32x4 x2 = *(const LAS f32x4*)(X + (pc * 2 + (fr & 1)) * 256 + p * 128 + colb + 4 * n);
                            const float s1 = fr == 0 ? 1.f : 0.f, s2 = fr < 2 ? 1.f : 0.f;
                            o = o + (x1 * s1) * w[p][1] + (x2 * s2) * w[p][0]; }
                        asm volatile("" : "+v"(o));
                        cv[p] = o;
                    }
                    f32x4 o;
#pragma unroll
                    for (int e = 0; e < 4; ++e) o[e] = gelu_tanh(cv[0][e]) * cv[1][e];
                    u32x2 pkd = (u32x2){cvtpk(o[0], o[1]), cvtpk(o[2], o[3])};
                    asm volatile("" : "+v"(pkd));
                    if (n == 0) stash[ai][m] = pkd;
                    else { const bool valid = !(chunk == 0 && m == 0 && fr < 2);
                        if (valid) *(u32x4*)(act + (size_t)(pm * 256 + ai * 128 + wr * 64 + m * 16 + fr) * D_FF + colA) = (u32x4){stash[ai][m].x, stash[ai][m].y, pkd.x, pkd.y}; }
                    __builtin_amdgcn_sched_barrier(0);
                }
        }
    }
};
#define XB_TMO      128
#define XB_XCNT(j)  (256  + 64 * (j))
#define XB_XSUB(j)  (1280 + 64 * (j))
#define XB_XGEN(j)  (2304 + 64 * (j))
#define XB_TOP      3328
#define XB_TOPGEN   3392
#define XCD_BAR_WORDS 3456
#define XB_SPIN_CAP (1u << 22)
__device__ __forceinline__ unsigned xb_ld(unsigned* p)              { return __hip_atomic_load(p, __ATOMIC_RELAXED, __HIP_MEMORY_SCOPE_AGENT); }
__device__ __forceinline__ unsigned xb_add(unsigned* p, unsigned v) { return __hip_atomic_fetch_add(p, v, __ATOMIC_RELAXED, __HIP_MEMORY_SCOPE_AGENT); }
__device__ __forceinline__ unsigned xb_xcc_id() { return (unsigned)__builtin_amdgcn_s_getreg((3 << 11) | 20) & 0xFu; }
#define XB_SPIN(cond, bar) do { unsigned _sp = 0; while (cond) { __builtin_amdgcn_s_sleep(1); \
    if ((++_sp & 255u) == 0u) { if (xb_ld(&(bar)[XB_TMO])) break; if (_sp > XB_SPIN_CAP) { atomicAdd(&(bar)[XB_TMO], 1u); break; } } } } while (0)
struct XcdBarrier { unsigned* bar; unsigned x; volatile LAS unsigned* st; };
__device__ __forceinline__ XcdBarrier xcd_barrier_post(unsigned* bar, volatile LAS unsigned* st) {
    XcdBarrier b; b.bar = bar; b.x = xb_xcc_id(); b.st = st;
    if (threadIdx.x == 0) (void)xb_add(&bar[XB_XCNT(b.x)], 1u);
    return b;
}
__device__ __forceinline__ void xcd_barrier_complete(unsigned* bar, unsigned x, unsigned& nloc, unsigned& nx) {
    const unsigned G = gridDim.x * gridDim.y * gridDim.z;
    unsigned sum, cnt, mine, sp = 0u;
    for (;;) {
        sum = 0u; cnt = 0u; mine = 0u;
#pragma unroll
        for (unsigned j = 0; j < 16; ++j) { const unsigned c = xb_ld(&bar[XB_XCNT(j)]); sum += c; cnt += (c > 0u) ? 1u : 0u; mine = (j == x) ? c : mine; }
        if (sum == G) break;
        __builtin_amdgcn_s_sleep(1);
        if ((++sp & 255u) == 0u) { if (xb_ld(&bar[XB_TMO])) break; if (sp > XB_SPIN_CAP) { atomicAdd(&bar[XB_TMO], 1u); break; } }
    }
    nloc = mine > 0u ? mine : 1u; nx = cnt > 0u ? cnt : 1u;
}
__device__ __forceinline__ void xcd_barrier(const XcdBarrier& b) {
    asm volatile("s_waitcnt vmcnt(0)" ::: "memory");
    __syncthreads();
    if (threadIdx.x == 0) {
        unsigned* bar = b.bar;
        __builtin_amdgcn_s_waitcnt(0);
        unsigned nloc = b.st[0], nx = b.st[1];
        if (nloc == 0u) { xcd_barrier_complete(bar, b.x, nloc, nx); b.st[0] = nloc; b.st[1] = nx; }
        const unsigned old = xb_add(&bar[XB_XSUB(b.x)], 1u);
        const unsigned gen = old / nloc;
        if (old + 1u == (gen + 1u) * nloc) {
            __builtin_amdgcn_fence(__ATOMIC_RELEASE, "agent");
            asm volatile("s_waitcnt vmcnt(0)" ::: "memory");
            const unsigned og = xb_add(&bar[XB_TOP], 1u);
            const unsigned tg = og / nx;
            if (og + 1u == (tg + 1u) * nx) xb_add(&bar[XB_TOPGEN], 1u);
            else XB_SPIN(xb_ld(&bar[XB_TOPGEN]) == tg, bar);
            __builtin_amdgcn_fence(__ATOMIC_ACQUIRE, "agent");
            xb_add(&bar[XB_XGEN(b.x)], 1u);
            asm volatile("s_waitcnt vmcnt(0)" ::: "memory");
        } else {
            XB_SPIN(xb_ld(&bar[XB_XGEN(b.x)]) == gen, bar);
            __builtin_amdgcn_fence(__ATOMIC_ACQUIRE, "agent");
            asm volatile("s_waitcnt vmcnt(0)" ::: "memory");
        }
    }
    __syncthreads();
}

constexpr size_t al(size_t x) { return (x + 4095) & ~(size_t)4095; }
constexpr size_t O_CTL = 0, CTL_BYTES = 65536;
constexpr size_t O_WIN = O_CTL + CTL_BYTES;
constexpr size_t O_WOT = O_WIN + al((size_t)PROJ_PAD * D_MODEL * 2);
constexpr size_t O_WOF = O_WOT + al((size_t)D_MODEL * D_MODEL * 2);
constexpr size_t O_WUP = O_WOF + al((size_t)D_MODEL * D_MODEL * 2);
constexpr size_t O_WDN = O_WUP + al((size_t)2 * D_FF * D_MODEL * 2);
constexpr size_t O_WUK = O_WDN + al((size_t)D_MODEL * D_FF * 2);
constexpr size_t O_WUVT = O_WUK + al((size_t)CKV * 1024 * 2);
constexpr size_t O_WPS = O_WUVT + al((size_t)1024 * CKV * 2);
constexpr size_t O_CKV = O_WPS + al((size_t)4 * PG * PG * 2);
constexpr size_t O_KIDX = O_CKV + al((size_t)RP * CKV * 2);
constexpr size_t O_WIDX = O_KIDX + al((size_t)RP * IDIM * 2);
constexpr size_t O_MASK = O_WIDX + al((size_t)RP * IH * 4);
constexpr size_t O_CAT = O_MASK + al((size_t)RP * MW * 4);
constexpr size_t O_H1 = O_CAT + al((size_t)RP * D_MODEL * 2);
constexpr size_t O_H1B = O_H1 + al((size_t)RREAL * D_MODEL * 4);
constexpr size_t O_HALO = O_H1B + al((size_t)RREAL * D_MODEL * 2);
constexpr size_t HALO_HEAD = 0, HALO_TAIL = (size_t)64 * 2 * D_FF * 4, HALO_ZMETA = 2 * HALO_TAIL, HALO_PREM = HALO_ZMETA + (size_t)2 * 2 * D_FF * 4, HALO_H1M = HALO_PREM + 2 * D_MODEL * 4, HALO_BYTES = HALO_H1M + 2 * D_MODEL * 4;
constexpr size_t O_X = O_HALO + al(HALO_BYTES);
constexpr size_t O_HB = O_X;
constexpr size_t O_Q = O_HB + al((size_t)RP * D_MODEL * 2);
constexpr size_t O_QIDX = O_Q + al((size_t)RP * 1024 * 2);
constexpr size_t O_U = O_QIDX + al((size_t)RP * 1024 * 2);
constexpr size_t O_CKVRAW = O_U + al((size_t)RP * 1024 * 2);
constexpr size_t O_SC = O_H1;
static_assert((size_t)BATCH * T * SCP * 4 <= (size_t)RREAL * D_MODEL * 6, "scores fit");
constexpr size_t O_ACT = O_X;
constexpr size_t X_END_A = O_CKVRAW + al((size_t)RP * CKV * 4), X_END_B = O_ACT + al((size_t)RREAL * D_FF * 2);
constexpr size_t WS_NEED = X_END_A > X_END_B ? X_END_A : X_END_B;
static_assert(WS_NEED <= (size_t)352 * 1024 * 1024, "workspace budget");
constexpr int CW_BAR = 0, CW_Q2 = 8192;

constexpr int LDS_BYTES = 163840;
constexpr int MISC_OFF = XOFF + 8192;

__device__ __forceinline__ int swap23(int p) { return (p & ~0xC) | ((p & 4) << 1) | ((p & 8) >> 1); }
template <bool KSWAP, class DR>
__device__ __forceinline__ void p0_transpose_item(const float* __restrict__ W, int K, int N, bf16_t* WT, int ldwt, const DR& dr, bf16_t* WT2, int k2lim, LAS float* scr, int item, int lane) {
    const int nblk = (N + 31) / 32, kb = item / nblk, nb = item % nblk, k0 = 64 * kb, n0 = 32 * nb;
    const int ncol = n0 + (lane & 31);
#pragma unroll 8
    for (int i = 0; i < 32; ++i) { const int kk = 2 * i + (lane >> 5); scr[kk * 33 + (lane & 31)] = ncol < N ? W[(size_t)(k0 + kk) * N + ncol] : 0.f; }
    asm volatile("s_waitcnt lgkmcnt(0)" ::: "memory");
    const int c = lane & 7;
#pragma unroll
    for (int j = 0; j < 4; ++j) { const int nl = (lane >> 3) + 8 * j, n = n0 + nl;
        float s[8];
#pragma unroll
        for (int e = 0; e < 8; ++e) { const int p = 8 * c + e; s[e] = scr[(KSWAP ? swap23(p) : p) * 33 + nl]; }
        u32x4 o; o.x = pk2(s[0], s[1]); o.y = pk2(s[2], s[3]); o.z = pk2(s[4], s[5]); o.w = pk2(s[6], s[7]);
        if (n < N) { const size_t row = (size_t)dr(n); *(u32x4*)(WT + row * ldwt + k0 + 8 * c) = o; if (WT2 && k0 < k2lim) *(u32x4*)(WT2 + row * ldwt + k0 + 8 * c) = o; } }
    asm volatile("s_waitcnt lgkmcnt(0)" ::: "memory");
}
struct DrId { __device__ __forceinline__ int operator()(int n) const { return n; } };
struct DrWin { __device__ __forceinline__ int operator()(int n) const {
    return n < 2304 ? n : (n < 2368 ? 3328 + (n - 2304) : (n < 2384 ? 3392 + (n - 2368) : 2304 + (n - 2384))); } };
struct DrWup { __device__ __forceinline__ int operator()(int n) const { const int p = n >= D_FF, m = n - p * D_FF; return (m >> 7) * 256 + p * 128 + (m & 127); } };

struct Ptrs {
    const float *x, *meta, *relb, *w_in, *kvg, *w_uk, *w_uv, *w_pool, *pscale, *w_o, *ln1g, *ln1b, *w_up, *convw, *convb, *w_dn, *ln2g, *ln2b; float* out; char* ws;
};

__device__ __forceinline__ void p0_prologue(const Ptrs& P, LAS unsigned char* lds, int wave, int lane, int G) {
    char* ws = P.ws;
    bf16_t *WinT = (bf16_t*)(ws + O_WIN), *WoT = (bf16_t*)(ws + O_WOT), *WoF = (bf16_t*)(ws + O_WOF), *WupT = (bf16_t*)(ws + O_WUP), *WdnT = (bf16_t*)(ws + O_WDN);
    bf16_t *wukb = (bf16_t*)(ws + O_WUK), *wuvT = (bf16_t*)(ws + O_WUVT), *wps = (bf16_t*)(ws + O_WPS), *hb = (bf16_t*)(ws + O_HB);
    LAS float* scr = (LAS float*)(lds + wave * 16384);
    const int gw = blockIdx.x * 8 + wave, NGW = G * 8;
    constexpr int I_IN = (D_MODEL / 64) * ((PROJ + 31) / 32), I_O = (D_MODEL / 64) * (D_MODEL / 32), I_UP = (D_MODEL / 64) * (2 * D_FF / 32), I_DN = (D_FF / 64) * (D_MODEL / 32), I_UV = (CKV / 64) * (1024 / 32);
    constexpr int NITEMS = I_IN + I_O + I_UP + I_DN + I_UV;
    for (int it = gw; it < NITEMS; it += NGW) {
        int r = it;
        if (r < I_UP) { p0_transpose_item<false>(P.w_up, D_MODEL, 2 * D_FF, WupT, D_MODEL, DrWup{}, nullptr, 0, scr, r, lane); continue; } r -= I_UP;
        if (r < I_DN) { p0_transpose_item<false>(P.w_dn, D_FF, D_MODEL, WdnT, D_FF, DrId{}, nullptr, 0, scr, r, lane); continue; } r -= I_DN;
        if (r < I_IN) { p0_transpose_item<false>(P.w_in, D_MODEL, PROJ, WinT, D_MODEL, DrWin{}, nullptr, 0, scr, r, lane); continue; } r -= I_IN;
        if (r < I_O) { p0_transpose_item<false>(P.w_o, D_MODEL, D_MODEL, WoT, D_MODEL, DrId{}, WoF, 1024, scr, r, lane); continue; } r -= I_O;
        p0_transpose_item<true>(P.w_uv, CKV, 1024, wuvT, CKV, DrId{}, nullptr, 0, scr, r, lane);
    }
    for (int i = gw * 64 + lane; i < (PROJ_PAD - PROJ) * D_MODEL / 8; i += NGW * 64) *(u32x4*)(WinT + (size_t)PROJ * D_MODEL + (size_t)i * 8) = (u32x4){0u, 0u, 0u, 0u};
    for (int i = gw * 64 + lane; i < CKV * 1024 / 4; i += NGW * 64) { const f32x4 v = *(const f32x4*)(P.w_uk + (size_t)i * 4); *(u32x2*)(wukb + (size_t)i * 4) = (u32x2){pk2(v[0], v[1]), pk2(v[2], v[3])}; }
    for (int i = gw * 64 + lane; i < 4 * PG * PG / 4; i += NGW * 64) { const f32x4 v = *(const f32x4*)(P.w_pool + (size_t)i * 4); const int e = i * 4, g = e / (PG * PG), j = e % PG;
        const f32x4 s = *(const f32x4*)(P.pscale + g * PG + j); *(u32x2*)(wps + (size_t)e) = (u32x2){pk2(v[0] * s[0], v[1] * s[1]), pk2(v[2] * s[2], v[3] * s[3])}; }
    for (int row = gw; row < RP; row += NGW) {
        const float* src = row < RREAL ? P.x + (size_t)row * D_MODEL : (row < R ? P.meta + (size_t)(row - RREAL) * D_MODEL : nullptr);
#pragma unroll
        for (int j = 0; j < 8; ++j) { const int c = 4 * lane + 256 * j; f32x4 v = (f32x4){0.f, 0.f, 0.f, 0.f}; if (src) v = *(const f32x4*)(src + c);
            *(u32x2*)(hb + (size_t)row * D_MODEL + c) = (u32x2){pk2(v[0], v[1]), pk2(v[2], v[3])}; }
    }
}
__device__ __forceinline__ void rmsnorm_row(const float* __restrict__ raw, const float* __restrict__ g, bf16_t* __restrict__ ckv, int row, int lane) {
    const f32x4 v = *(const f32x4*)(raw + (size_t)row * CKV + lane * 4);
    float s = v[0] * v[0] + v[1] * v[1] + v[2] * v[2] + v[3] * v[3];
#pragma unroll
    for (int o = 1; o < 64; o <<= 1) s += __shfl_xor(s, o);
    const float r = 1.0f / sqrtf(s * (1.0f / CKV) + LN_EPS);
    const f32x4 gg = *(const f32x4*)(g + lane * 4);
    *(u32x2*)(ckv + (size_t)row * CKV + lane * 4) = (u32x2){pk2(v[0] * r * gg[0], v[1] * r * gg[1]), pk2(v[2] * r * gg[2], v[3] * r * gg[3])};
}
__device__ __forceinline__ void nv_scores(const bf16_t* __restrict__ qidx, const bf16_t* __restrict__ kidx, const float* __restrict__ widx, float* __restrict__ sc, int b, int t, LAS unsigned char* lds) {
    LAS float* sq = (LAS float*)lds; LAS float* sw = sq + IH * IDIM;
    const int rq = rid(b, t), tid = threadIdx.x;
    __syncthreads();
    for (int i = tid; i < IH * IDIM; i += 512) sq[i] = bf2f(qidx[(size_t)rq * 1024 + i]);
    if (tid < IH) sw[tid] = widx[(size_t)rq * IH + tid];
    __syncthreads();
    for (int s = tid; s <= t; s += 512) {
        const bf16_t* kp = kidx + (size_t)rid(b, s) * IDIM; float k[IDIM];
#pragma unroll
        for (int i = 0; i < IDIM; i += 8) { const u32x4 w = *(const u32x4*)(kp + i);
            k[i] = bflo(w.x); k[i + 1] = bfhi(w.x); k[i + 2] = bflo(w.y); k[i + 3] = bfhi(w.y); k[i + 4] = bflo(w.z); k[i + 5] = bfhi(w.z); k[i + 6] = bflo(w.w); k[i + 7] = bfhi(w.w); }
        float score = 0.f;
        for (int h = 0; h < IH; ++h) { float d = 0.f;
#pragma unroll
            for (int i = 0; i < IDIM; ++i) d = fmaf(sq[h * IDIM + i], k[i], d);
            score = fmaf(sw[h], fmaxf(d, 0.f), score); }
        sc[((size_t)b * T + t) * SCP + s] = score;
    }
}
__device__ __forceinline__ unsigned fkey(float f) { const unsigned u = __builtin_bit_cast(unsigned, f); return (u & 0x80000000u) ? ~u : (u | 0x80000000u); }
__device__ __forceinline__ void topk_emit(unsigned (&key)[33], int t, unsigned* mrow, int lane) {
    constexpr int NI = 33;
    if (t + 1 <= TOPK) {
#pragma unroll
        for (int i = 0; i < NI; ++i) { const int s = i * 64 + lane; const unsigned long long m = __ballot(s <= t);
            if (lane == 0) { mrow[2 * i] = (unsigned)m; mrow[2 * i + 1] = (unsigned)(m >> 32); } }
        if (lane < MW - 2 * NI) mrow[2 * NI + lane] = 0u;
        return;
    }
    unsigned thr = 0u;
    for (int bit = 31; bit >= 0; --bit) {
        const unsigned cand = thr | (1u << bit); int c = 0;
#pragma unroll
        for (int i = 0; i < NI; ++i) c += (key[i] >= cand) ? 1 : 0;
#pragma unroll
        for (int o = 1; o < 64; o <<= 1) c += __shfl_xor(c, o);
        if (c >= TOPK) thr = cand;
    }
    int cgt = 0;
#pragma unroll
    for (int i = 0; i < NI; ++i) cgt += (key[i] > thr) ? 1 : 0;
#pragma unroll
    for (int o = 1; o < 64; o <<= 1) cgt += __shfl_xor(cgt, o);
    int need = TOPK - cgt;
#pragma unroll
    for (int i = 0; i < NI; ++i) {
        const bool eq = key[i] == thr; const unsigned long long em = __ballot(eq);
        const int before = __popcll(em & ((1ull << lane) - 1ull));
        const bool sel = (key[i] > thr) || (eq && before < need);
        need -= __popcll(em); if (need < 0) need = 0;
        const unsigned long long m = __ballot(sel);
        if (lane == 0) { mrow[2 * i] = (unsigned)m; mrow[2 * i + 1] = (unsigned)(m >> 32); }
    }
    if (lane < MW - 2 * NI) mrow[2 * NI + lane] = 0u;
}
__device__ __forceinline__ void nv_topk_row(const float* __restrict__ sc, unsigned* __restrict__ mask, int b, int t, int lane) {
    unsigned key[33]; const float* srow = sc + ((size_t)b * T + t) * SCP;
#pragma unroll
    for (int i = 0; i < 33; ++i) { const int s = i * 64 + lane; key[i] = (s <= t && t + 1 > TOPK) ? fkey(srow[s]) : 0u; }
    topk_emit(key, t, mask + (size_t)rid(b, t) * MW, lane);
}
__device__ __forceinline__ void nv_pooldiff(const bf16_t* __restrict__ u, bf16_t* __restrict__ cat, int b, int t) {
    for (int c = threadIdx.x; c < POOLW; c += 512) {
        const int w = 2 << (c / PG); const int cntw = (t + 1) < w ? (t + 1) : w; float s = 0.f;
        for (int i = cntw - 1; i >= 0; --i) s += bf2f(u[(size_t)rid(b, t - i) * POOLW + c]);
        const float cur = bf2f(u[(size_t)rid(b, t) * POOLW + c]);
        cat[(size_t)rid(b, t) * D_MODEL + 1024 + c] = (bf16_t)f2bf(s / (float)cntw - cur);
    }
}
__device__ __forceinline__ void nv_attn(const bf16_t* __restrict__ q, const bf16_t* __restrict__ wukb, const bf16_t* __restrict__ wuvT, const bf16_t* __restrict__ ckv,
                                        const unsigned* __restrict__ mask, const float* __restrict__ relb, bf16_t* __restrict__ cat, int b, int t, LAS unsigned char* lds) {
    LAS float* sqa = (LAS float*)lds;
    LAS float* sp = sqa + NH * CKV;
    LAS float* so = sp + NH * TOPK;
    LAS float* qrow = so + NH * CKV;
    LAS float* red = qrow + 1024;
    LAS int* sel = (LAS int*)(red + 32);
    LAS int* woff = sel + TOPK;
    const int tid = threadIdx.x, rq = rid(b, t), lane = tid & 63, wid = tid >> 6;
    const unsigned* mrow = mask + (size_t)rq * MW;
    __syncthreads();
    for (int i = tid; i < 1024; i += 512) qrow[i] = bf2f(q[(size_t)rq * 1024 + i]);
    if (tid < 65) woff[tid] = __popc(mrow[tid]);
    __syncthreads();
    if (tid == 0) { int a = 0; for (int i = 0; i < 65; ++i) { const int c = woff[i]; woff[i] = a; a += c; } woff[65] = a; }
    __syncthreads();
    if (tid < 65) { unsigned w = mrow[tid]; int p = woff[tid]; while (w) { const int bit = __ffs((int)w) - 1; w &= w - 1; if (p < TOPK) sel[p] = tid * 32 + bit; ++p; } }
    for (int o = tid; o < NH * CKV; o += 512) { const int h = o >> 8, c = o & 255; const bf16_t* wp = wukb + (size_t)c * 1024 + h * HD; float a = 0.f;
        for (int d = 0; d < HD; d += 8) { const u32x4 w = *(const u32x4*)(wp + d); const LAS float* qp = qrow + h * HD + d;
            a = fmaf(qp[0], bflo(w.x), a); a = fmaf(qp[1], bfhi(w.x), a); a = fmaf(qp[2], bflo(w.y), a); a = fmaf(qp[3], bfhi(w.y), a);
            a = fmaf(qp[4], bflo(w.z), a); a = fmaf(qp[5], bfhi(w.z), a); a = fmaf(qp[6], bflo(w.w), a); a = fmaf(qp[7], bfhi(w.w), a); }
        sqa[o] = bf2f((bf16_t)f2bf(a)); }
    __syncthreads();
    const int ns = woff[65] < TOPK ? woff[65] : TOPK;
    const int k = tid & 255, hh = tid >> 8;
    const int s = k < ns ? sel[k] : 0; const bf16_t* kp = ckv + (size_t)rid(b, s) * CKV;
    float lg[4] = {0.f, 0.f, 0.f, 0.f};
    for (int c = 0; c < CKV; c += 8) { const u32x4 w = *(const u32x4*)(kp + c); float kv[8];
        kv[0] = bflo(w.x); kv[1] = bfhi(w.x); kv[2] = bflo(w.y); kv[3] = bfhi(w.y); kv[4] = bflo(w.z); kv[5] = bfhi(w.z); kv[6] = bflo(w.w); kv[7] = bfhi(w.w);
#pragma unroll
        for (int i = 0; i < 4; ++i)
#pragma unroll
            for (int j = 0; j < 8; ++j) lg[i] = fmaf(sqa[(hh * 4 + i) * CKV + c + j], kv[j], lg[i]); }
    int dist = t - s; if (dist < 0) dist = 0; const int bk = dist < 128 ? T5_BUCKET[dist] : 31;
#pragma unroll
    for (int i = 0; i < 4; ++i) { const int h = hh * 4 + i;
        const float x = k < ns ? lg[i] * 0.08838834764831845f + relb[bk * NH + h] : -INFINITY;
        float m = x;
#pragma unroll
        for (int o = 1; o < 64; o <<= 1) m = fmaxf(m, __shfl_xor(m, o));
        if (lane == 0) red[wid] = m; __syncthreads();
        m = fmaxf(fmaxf(red[hh * 4], red[hh * 4 + 1]), fmaxf(red[hh * 4 + 2], red[hh * 4 + 3])); __syncthreads();
        const float e = k < ns ? __expf(x - m) : 0.f; float sum = e;
#pragma unroll
        for (int o = 1; o < 64; o <<= 1) sum += __shfl_xor(sum, o);
        if (lane == 0) red[16 + wid] = sum; __syncthreads();
        sum = (red[16 + hh * 4] + red[16 + hh * 4 + 1]) + (red[16 + hh * 4 + 2] + red[16 + hh * 4 + 3]);
        sp[h * TOPK + k] = bf2f((bf16_t)f2bf(e / sum)); __syncthreads(); }
    { float o[4] = {0.f, 0.f, 0.f, 0.f}; const int c = k;
      for (int kk = 0; kk < ns; ++kk) { const float v = bf2f(ckv[(size_t)rid(b, sel[kk]) * CKV + c]);
#pragma unroll
          for (int i = 0; i < 4; ++i) o[i] = fmaf(sp[(hh * 4 + i) * TOPK + kk], v, o[i]); }
#pragma unroll
      for (int i = 0; i < 4; ++i) so[(hh * 4 + i) * CKV + c] = bf2f((bf16_t)f2bf(o[i])); }
    __syncthreads();
    for (int n = tid; n < 1024; n += 512) { const int h = n >> 7; const bf16_t* wp = wuvT + (size_t)n * CKV; float a = 0.f;
        for (int p = 0; p < CKV; p += 8) { const u32x4 w = *(const u32x4*)(wp + p); const LAS float* op = so + h * CKV;
            a = fmaf(op[swap23(p + 0)], bflo(w.x), a); a = fmaf(op[swap23(p + 1)], bfhi(w.x), a); a = fmaf(op[swap23(p + 2)], bflo(w.y), a); a = fmaf(op[swap23(p + 3)], bfhi(w.y), a);
            a = fmaf(op[swap23(p + 4)], bflo(w.z), a); a = fmaf(op[swap23(p + 5)], bfhi(w.z), a); a = fmaf(op[swap23(p + 6)], bflo(w.w), a); a = fmaf(op[swap23(p + 7)], bfhi(w.w), a); }
        cat[(size_t)rq * D_MODEL + n] = (bf16_t)f2bf(a); }
}
__device__ __forceinline__ void ln_row(const float* __restrict__ pre, const float* __restrict__ g, const float* __restrict__ bb, float* of32, bf16_t* obf, int lane) {
    f32x4 v[8]; float s = 0.f;
#pragma unroll
    for (int j = 0; j < 8; ++j) { v[j] = *(const f32x4*)(pre + 4 * lane + 256 * j); s += (v[j][0] + v[j][1]) + (v[j][2] + v[j][3]); }
#pragma unroll
    for (int o = 1; o < 64; o <<= 1) s += __shfl_xor(s, o);
    const float mean = s * (1.0f / D_MODEL); float q = 0.f;
#pragma unroll
    for (int j = 0; j < 8; ++j) { v[j] = v[j] - mean; q += (v[j][0] * v[j][0] + v[j][1] * v[j][1]) + (v[j][2] * v[j][2] + v[j][3] * v[j][3]); }
#pragma unroll
    for (int o = 1; o < 64; o <<= 1) q += __shfl_xor(q, o);
    const float rstd = 1.0f / sqrtf(q * (1.0f / D_MODEL) + LN_EPS);
#pragma unroll
    for (int j = 0; j < 8; ++j) { const int c = 4 * lane + 256 * j; const f32x4 gg = *(const f32x4*)(g + c), be = *(const f32x4*)(bb + c); const f32x4 o = v[j] * rstd * gg + be;
        if (of32) *(f32x4*)(of32 + c) = o;
        if (obf) *(u32x2*)(obf + c) = (u32x2){pk2(o[0], o[1]), pk2(o[2], o[3])}; }
}
__device__ __forceinline__ float dot2048(const bf16_t* __restrict__ a, const bf16_t* __restrict__ b, int lane) {
    float s = 0.f;
#pragma unroll
    for (int j = 0; j < 4; ++j) { const u32x4 x = *(const u32x4*)(a + lane * 8 + 512 * j), y = *(const u32x4*)(b + lane * 8 + 512 * j);
        s = fmaf(bflo(x.x), bflo(y.x), s); s = fmaf(bfhi(x.x), bfhi(y.x), s); s = fmaf(bflo(x.y), bflo(y.y), s); s = fmaf(bfhi(x.y), bfhi(y.y), s);
        s = fmaf(bflo(x.z), bflo(y.z), s); s = fmaf(bfhi(x.z), bfhi(y.z), s); s = fmaf(bflo(x.w), bflo(y.w), s); s = fmaf(bfhi(x.w), bfhi(y.w), s); }
#pragma unroll
    for (int o = 1; o < 64; o <<= 1) s += __shfl_xor(s, o);
    return s;
}
#ifndef PH
#define PH 0x7ff
#endif
struct Args { Ptrs p; };

__global__ void __launch_bounds__(512, 2) mega(Args args) {
    extern __shared__ __attribute__((aligned(16))) unsigned char lds_raw[];
    LAS unsigned char* lds = (LAS unsigned char*)lds_raw;
    const int tid = threadIdx.x, lane = tid & 63, wave = __builtin_amdgcn_readfirstlane(tid >> 6);
    const int G = gridDim.x, blk = blockIdx.x;
    volatile LAS unsigned* MISC = (volatile LAS unsigned*)(lds + MISC_OFF);
    if (tid < 16) MISC[tid] = 0u;
    __syncthreads();
    XcdBarrier bar = xcd_barrier_post((unsigned*)(args.p.ws + O_CTL) + CW_BAR, MISC + 8);
    const int gw = blk * 8 + wave, NGW = G * 8;
#define WSP(T_, off) ((T_*)(args.p.ws + (off)))

#if PH & 1
    p0_prologue(args.p, lds, wave, lane, G);
    xcd_barrier(bar);

#endif
#if PH & 2
    { pg8::Gemm g{WSP(bf16_t, O_HB), WSP(bf16_t, O_WIN)}; pg8::StaticOrder S; S.init(RP, PROJ_PAD, G, blk);
      EpiProj E{WSP(bf16_t, O_Q), WSP(float, O_CKVRAW), WSP(bf16_t, O_QIDX), WSP(bf16_t, O_U), WSP(bf16_t, O_KIDX), WSP(float, O_WIDX)};
      pg8::gemm_phase<EpiProj, pg8::StaticOrder, true, true, D_MODEL, D_MODEL, D_MODEL>(lds, g, S, E); }
    xcd_barrier(bar);

#endif
#if PH & 4
    for (int row = gw; row < R; row += NGW) rmsnorm_row(WSP(float, O_CKVRAW), args.p.kvg, WSP(bf16_t, O_CKV), row, lane);
    if (blk < 32) { const int gi = blk >> 3, nt = blk & 7;
        pg8::Gemm g{WSP(bf16_t, O_WOT) + 1024 + 256 * gi, WSP(bf16_t, O_WPS) + (size_t)gi * PG * PG}; pg8::OneUnit S{{nt, 0}};
        EpiBf16P E{WSP(bf16_t, O_WOF) + 1024 + 256 * gi, D_MODEL};
        pg8::gemm_phase<EpiBf16P, pg8::OneUnit, true, true, PG, D_MODEL, PG>(lds, g, S, E); }
    for (int it = blk; it < BATCH * T; it += G) { const int b = it / T, t = it % T; nv_scores(WSP(bf16_t, O_QIDX), WSP(bf16_t, O_KIDX), WSP(float, O_WIDX), WSP(float, O_SC), b, t, lds); }
    for (int it = blk; it < BATCH * T; it += G) { const int b = it / T, t = it % T; if (b == 0 || t >= N_META) nv_pooldiff(WSP(bf16_t, O_U), WSP(bf16_t, O_CAT), b, t); }
    xcd_barrier(bar);
#endif
#if PH & 8
    for (int it = gw; it < BATCH * T; it += NGW) { const int b = it / T, t = it % T; if (b == 0 || t >= N_META) nv_topk_row(WSP(float, O_SC), WSP(unsigned, O_MASK), b, t, lane); }
    xcd_barrier(bar);
#endif
#if PH & 16
    for (int it = blk; it < BATCH * T; it += G) { const int b = it / T, t = it % T;
        if (b == 0 || t >= N_META) nv_attn(WSP(bf16_t, O_Q), WSP(bf16_t, O_WUK), WSP(bf16_t, O_WUVT), WSP(bf16_t, O_CKV), WSP(unsigned, O_MASK), args.p.relb, WSP(bf16_t, O_CAT), b, t, lds); }
    xcd_barrier(bar);

#endif
#if PH & 32
    { pg8::Gemm g{WSP(bf16_t, O_CAT), WSP(bf16_t, O_WOF)}; pg8::StaticOrder S; S.init(RREAL, D_MODEL, G, blk);
      EpiPre E{args.p.x, WSP(float, O_H1), D_MODEL};
      pg8::gemm_phase<EpiPre, pg8::StaticOrder, true, true, D_MODEL, D_MODEL, D_MODEL>(lds, g, S, E); }
    { const int r = wave & 1; float* premeta = WSP(float, O_HALO + HALO_PREM);
#pragma unroll
      for (int j = 0; j < 2; ++j) { const int col = 8 * blk + (wave >> 1) * 2 + j;
          if (col < D_MODEL) { const float d = dot2048(WSP(bf16_t, O_CAT) + (size_t)(RREAL + 14 + r) * D_MODEL, WSP(bf16_t, O_WOF) + (size_t)col * D_MODEL, lane);
              if (lane == 0) premeta[r * D_MODEL + col] = ALPHA * args.p.meta[(size_t)(14 + r) * D_MODEL + col] + d; } } }
    xcd_barrier(bar);
#endif
#if PH & 64
    for (int row = gw; row < RREAL + 2; row += NGW) {
        if (row < RREAL) ln_row(WSP(float, O_H1) + (size_t)row * D_MODEL, args.p.ln1g, args.p.ln1b, WSP(float, O_H1) + (size_t)row * D_MODEL, WSP(bf16_t, O_H1B) + (size_t)row * D_MODEL, lane);
        else ln_row(WSP(float, O_HALO + HALO_PREM) + (size_t)(row - RREAL) * D_MODEL, args.p.ln1g, args.p.ln1b, nullptr, WSP(bf16_t, O_HALO + HALO_H1M) + (size_t)(row - RREAL) * D_MODEL, lane); }
    xcd_barrier(bar);

#endif
#if PH & 128
    for (int i = wave; i < 44; i += 8) { const int col = blk * 44 + i;
        if (col < 2 * D_FF) {
#pragma unroll
            for (int r = 0; r < 2; ++r) { const float d = dot2048(WSP(bf16_t, O_HALO + HALO_H1M) + (size_t)r * D_MODEL, WSP(bf16_t, O_WUP) + (size_t)col * D_MODEL, lane);
                if (lane == 0) WSP(float, O_HALO + HALO_ZMETA)[(size_t)r * 2 * D_FF + col] = d; } } }
    { pg8::Gemm g{WSP(bf16_t, O_H1B), WSP(bf16_t, O_WUP)}; pg8::StaticOrder S; S.init(RREAL, 2 * D_FF, G, blk);
      EpiConv E{WSP(bf16_t, O_ACT), WSP(float, O_HALO + HALO_HEAD), WSP(float, O_HALO + HALO_TAIL), args.p.convw, args.p.convb};
      pg8::gemm_phase<EpiConv, pg8::StaticOrder, true, true, D_MODEL, D_MODEL, D_MODEL>(lds, g, S, E); }
    xcd_barrier(bar);
#endif
#if PH & 256
    { const float *head = WSP(float, O_HALO + HALO_HEAD), *tail = WSP(float, O_HALO + HALO_TAIL), *zmeta = WSP(float, O_HALO + HALO_ZMETA); const float *convw = args.p.convw, *convb = args.p.convb; bf16_t* act = WSP(bf16_t, O_ACT);
    for (int it = blk * 512 + tid; it < 32 * 2 * D_FF; it += G * 512) {
        const int n = it % D_FF, rr = (it / D_FF) & 1, pm = it / (2 * D_FF);
        const int pn = n >> 7, i = n & 127; const int ca = pn * 256 + i, cg = ca + 128;
        const float* s0 = (pm & 7) == 0 ? zmeta : tail + (size_t)(pm - 1) * 2 * 2 * D_FF;
        const float* s1 = head + (size_t)pm * 2 * 2 * D_FF;
        const float zam2 = s0[ca], zgm2 = s0[cg], zam1 = s0[2 * D_FF + ca], zgm1 = s0[2 * D_FF + cg], za0 = s1[ca], zg0 = s1[cg], za1 = s1[2 * D_FF + ca], zg1 = s1[2 * D_FF + cg];
        const float a0 = rr ? zam1 : zam2, a1 = rr ? za0 : zam1, a2 = rr ? za1 : za0, g0 = rr ? zgm1 : zgm2, g1 = rr ? zg0 : zgm1, g2 = rr ? zg1 : zg0;
        float a = convb[n], gt = convb[D_FF + n];
        a = fmaf(a0, convw[n], a); a = fmaf(a1, convw[(size_t)2 * D_FF + n], a); a = fmaf(a2, convw[(size_t)4 * D_FF + n], a);
        gt = fmaf(g0, convw[D_FF + n], gt); gt = fmaf(g1, convw[(size_t)3 * D_FF + n], gt); gt = fmaf(g2, convw[(size_t)5 * D_FF + n], gt);
        act[(size_t)(pm * 256 + rr) * D_FF + n] = (bf16_t)f2bf(gelu_tanh(a) * gt);
    } }
    xcd_barrier(bar);

#endif
#if PH & 512
    { pg8::Gemm g{WSP(bf16_t, O_ACT), WSP(bf16_t, O_WDN)}; pg8::StaticOrder S; S.init(RREAL, D_MODEL, G, blk);
      EpiPre E{WSP(float, O_H1), args.p.out, D_MODEL};
      pg8::gemm_phase<EpiPre, pg8::StaticOrder, true, true, D_FF, D_FF, D_FF>(lds, g, S, E); }
    xcd_barrier(bar);
#endif
#if PH & 1024
    for (int row = gw; row < RREAL; row += NGW) ln_row(args.p.out + (size_t)row * D_MODEL, args.p.ln2g, args.p.ln2b, args.p.out + (size_t)row * D_MODEL, nullptr, lane);
#endif
#undef WSP
}

extern "C" void kernel_launch(void* const* d_in, const int* in_sizes, int n_in, void* d_out, int out_size, void* d_ws, size_t ws_size, hipStream_t stream) {
    static int grid = 0;
    if (grid == 0) {
        if (ws_size < WS_NEED || n_in != 18) { fprintf(stderr, "kernel_launch: bad workspace/inputs: ws %zu need %zu n_in %d\n", ws_size, (size_t)WS_NEED, n_in); grid = -1; return; }
        int dev = 0, cus = 0;
        (void)hipGetDevice(&dev); (void)hipDeviceGetAttribute(&cus, hipDeviceAttributeMultiprocessorCount, dev);
        if (hipFuncSetAttribute((const void*)mega, hipFuncAttributeMaxDynamicSharedMemorySize, LDS_BYTES) != hipSuccess) { fprintf(stderr, "kernel_launch: hipFuncSetAttribute failed\n"); grid = -1; return; }
        grid = cus;
    }
    if (grid < 0) return;
    (void)hipMemsetAsync((char*)d_ws + O_CTL, 0, CTL_BYTES, stream);
    Args a{};
    const float** pp = (const float**)&a.p;
    for (int i = 0; i < 18; ++i) pp[i] = (const float*)d_in[i];
    a.p.out = (float*)d_out; a.p.ws = (char*)d_ws;
    hipLaunchKernelGGL(mega, dim3(grid), dim3(512), LDS_BYTES, stream, a);
}
```

```cpp
#include <hip/hip_runtime.h>
#include <cstdint>
#include <cstdio>

typedef unsigned short bf16_t;
typedef short bf16x8 __attribute__((ext_vector_type(8)));
typedef float f32x4 __attribute__((ext_vector_type(4)));
typedef float f32x2 __attribute__((ext_vector_type(2)));
typedef float f32x16 __attribute__((ext_vector_type(16)));
typedef unsigned u32x4 __attribute__((ext_vector_type(4)));
typedef unsigned u32x2 __attribute__((ext_vector_type(2)));
#define LAS __attribute__((address_space(3)))
#define GAS __attribute__((address_space(1)))

constexpr int D_MODEL = 2048, BATCH = 4, SEQ = 2048, N_META = 16, T = SEQ + N_META;
constexpr int NH = 8, HD = 128, CKV = 256, IH = 16, IDIM = 64, TOPK = 256;
constexpr int POOLW = 1024, PG = 256, D_FF = 5632;
constexpr int PROJ = 3408, PROJ_PAD = 3584;
constexpr int R = BATCH * SEQ + N_META;
constexpr int RREAL = BATCH * SEQ;
constexpr int RP = 8448;
constexpr float ALPHA = 1.189207115002721f;
constexpr float LN_EPS = 1e-5f;
constexpr int MW = 68;
constexpr int SCP = 2080;

__host__ __device__ __forceinline__ int rid(int b, int t) { return t < N_META ? RREAL + t : b * SEQ + (t - N_META); }
__device__ __forceinline__ unsigned f2bf(float f) { unsigned u = __builtin_bit_cast(unsigned, f); return (u + 0x7fffu + ((u >> 16) & 1u)) >> 16; }
__device__ __forceinline__ unsigned pk2(float lo, float hi) { return f2bf(lo) | (f2bf(hi) << 16); }
__device__ __forceinline__ float bf2f(bf16_t h) { return __builtin_bit_cast(float, (unsigned)h << 16); }
__device__ __forceinline__ float bflo(unsigned w) { return __builtin_bit_cast(float, w << 16); }
__device__ __forceinline__ float bfhi(unsigned w) { return __builtin_bit_cast(float, w & 0xffff0000u); }

__device__ const unsigned char T5_BUCKET[128] = {
    0, 1, 2, 3, 4, 5, 6, 7, 8, 9, 10, 11, 12, 13, 14, 15, 16, 16, 16, 17, 17, 18, 18, 18, 19, 19, 19, 20, 20, 20, 20, 21, 21, 21, 21, 22, 22, 22, 22, 22,
    23, 23, 23, 23, 23, 23, 24, 24, 24, 24, 24, 24, 25, 25, 25, 25, 25, 25, 25, 26, 26, 26, 26, 26, 26, 26, 26, 27, 27, 27, 27, 27, 27, 27, 27, 27, 27,
    28, 28, 28, 28, 28, 28, 28, 28, 28, 28, 29, 29, 29, 29, 29, 29, 29, 29, 29, 29, 29, 29, 30, 30, 30, 30, 30, 30, 30, 30, 30, 30, 30, 30, 30, 30,
    31, 31, 31, 31, 31, 31, 31, 31, 31, 31, 31, 31, 31, 31, 31};

namespace pg8 {
constexpr int BM = 256, BK = 64, HALF = 128, HTB = HALF * BK * 2  , STAGE_BYTES = 8 * HTB, NXCD = 8, WGM = 8;
__host__ __device__ __forceinline__ int lds_byte(int r, int c) { const int st = (r >> 4) * 2 + (c >> 5), rr = r & 15, cc = c & 31, ob = rr * 64 + cc * 2; return st * 1024 + (ob ^ (((ob >> 9) & 1) << 5)); }
__host__ __device__ __forceinline__ void stage_rc(int b, int& R_, int& C) { const int st = b / 1024, sb = b % 1024, swz = sb ^ (((sb >> 9) & 1) << 5); R_ = (st >> 1) * 16 + swz / 64; C = (st & 1) * 32 + (swz % 64) / 2; }
__host__ __device__ __forceinline__ int perm32(int rho) { const int n = rho >> 4, i = rho & 15; return 8 * (i >> 2) + 4 * n + (i & 3); }
struct Unit { int pm, pn; };
struct Gemm { const bf16_t* A; const bf16_t* Bt; };

struct StaticOrder {
    int nM, nN, nwg, G, c;
    __host__ __device__ void init(int M, int N, int G_, int c_) { nM = M / BM; nN = N / BM; nwg = nM * nN; G = G_; c = c_; }
    __host__ __device__ bool next(int i, Unit& u) const {
        const long L = (long)i * G + c; if (L >= nwg) return false;
        int wgid = (int)L; { const int q = nwg / NXCD, r = nwg % NXCD, xcd = wgid % NXCD, off = wgid / NXCD; wgid = (xcd < r ? xcd * (q + 1) : r * (q + 1) + (xcd - r) * q) + off; }
        const int nig = WGM * nN, gid = wgid / nig, fm = gid * WGM, gsz = (nM - fm) < WGM ? (nM - fm) : WGM;
        u.pm = fm + ((wgid % nig) % gsz); u.pn = (wgid % nig) / gsz; return true;
    }
};
struct OneUnit { Unit u; __device__ bool next(int i, Unit& o) const { if (i > 0) return false; o = u; return true; } };

template <class Epi, class Sched, bool ALIGN_EPI, bool SP2, int K, int LDA, int LDB>
__device__ __forceinline__ void gemm_phase(LAS unsigned char* lds, const Gemm g, const Sched& S, const Epi& E) {
    int tid = threadIdx.x; asm volatile("" : "+v"(tid));
    const int wid = __builtin_amdgcn_readfirstlane(tid >> 6), lane = tid & 63, wr = wid >> 2, wc = wid & 3, fr = lane & 15, fq = lane >> 4;
    constexpr int nt = K / BK;
    unsigned voffA[2], voffB[2];
#pragma unroll
    for (int i = 0; i < 2; ++i) { int R_, C; stage_rc(tid * 16 + i * 8192, R_, C); const int Rb = Epi::PERM ? ((R_ & ~31) + perm32(R_ & 31)) : R_;
        voffA[i] = (unsigned)(R_ * LDA + C) * 2u; voffB[i] = (unsigned)(Rb * LDB + C) * 2u; }
    constexpr size_t kstep = (size_t)(BK * 2);
    constexpr size_t hstepA = (size_t)HALF * LDA * 2, hstepB = (size_t)HALF * LDB * 2;
    constexpr size_t tstepA = 2 * hstepA, tstepB = 2 * hstepB;
    const unsigned ldsw = (unsigned)wid * 1024u;
    const int aoff = lds_byte(wr * 64 + fr, fq * 8), boff = lds_byte(wc * 32 + fr, fq * 8);
#define PG8_SA(b, h) (((b) * 2 + (h)) * HTB)
#define PG8_SB(b, h) ((4 + (b) * 2 + (h)) * HTB)
#define PG8_STAGE(bufoff, gbase, voff) do { _Pragma("unroll") for (int _i = 0; _i < 2; ++_i) \
        __builtin_amdgcn_global_load_lds((const unsigned*)((const char*)(gbase) + (voff)[_i]), (LAS unsigned*)(lds + (bufoff) + ldsw + _i * 8192), 16, 0, 0); } while (0)
#define PG8_LDA(dst, b, h) do { _Pragma("unroll") for (int m = 0; m < 4; ++m) _Pragma("unroll") for (int k = 0; k < 2; ++k) dst[m][k] = *(const LAS bf16x8*)(lds + PG8_SA(b, h) + aoff + m * 2048 + k * 1024); } while (0)
#define PG8_LDB(dst, b, h) do { _Pragma("unroll") for (int n = 0; n < 2; ++n) _Pragma("unroll") for (int k = 0; k < 2; ++k) dst[n][k] = *(const LAS bf16x8*)(lds + PG8_SB(b, h) + boff + n * 2048 + k * 1024); } while (0)
#define PG8_MMA(ai, bj, At, Bt) do { __builtin_amdgcn_s_setprio(1); _Pragma("unroll") for (int m = 0; m < 4; ++m) _Pragma("unroll") for (int n = 0; n < 2; ++n) _Pragma("unroll") for (int k = 0; k < 2; ++k) \
        acc[ai][bj][m][n] = __builtin_amdgcn_mfma_f32_16x16x32_bf16(Bt[n][k], At[m][k], acc[ai][bj][m][n], 0, 0, 0); __builtin_amdgcn_s_setprio(0); } while (0)
#define PG8_WAIT_V(n) asm volatile("s_waitcnt vmcnt(" #n ")" ::: "memory")
#define PG8_WAIT_L(n) asm volatile("s_waitcnt lgkmcnt(" #n ")" ::: "memory")
#define PG8_BAR __builtin_amdgcn_s_barrier()
#define PG8_SCHED __builtin_amdgcn_sched_barrier(0)
    Unit cur, nxt; int ui = 0;
    if (!S.next(0, cur)) return;
    f32x4 acc[2][2][4][2];
#pragma unroll
    for (int a = 0; a < 2; ++a)
#pragma unroll
        for (int b = 0; b < 2; ++b)
#pragma unroll
            for (int m = 0; m < 4; ++m)
#pragma unroll
                for (int n = 0; n < 2; ++n) acc[a][b][m][n] = (f32x4){0.f, 0.f, 0.f, 0.f};
    bf16x8 At[4][2], B0[2][2], B1[2][2];
    const char* cA = (const char*)g.A + (size_t)cur.pm * tstepA; const char* cB = (const char*)g.Bt + (size_t)cur.pn * tstepB;
    if constexpr (SP2) {
        PG8_STAGE(PG8_SB(0, 0), cB, voffB); PG8_STAGE(PG8_SB(0, 1), cB + hstepB, voffB); PG8_STAGE(PG8_SA(0, 0), cA, voffA); PG8_STAGE(PG8_SA(0, 1), cA + hstepA, voffA);
        if (wr == 1) PG8_BAR;
        PG8_WAIT_V(2); PG8_BAR;
        PG8_STAGE(PG8_SB(1, 0), cB + kstep, voffB); PG8_STAGE(PG8_SA(1, 0), cA + kstep, voffA); PG8_STAGE(PG8_SB(1, 1), cB + hstepB + kstep, voffB);
        PG8_WAIT_V(6); PG8_BAR;
    } else {
        PG8_STAGE(PG8_SB(0, 0), cB, voffB); PG8_STAGE(PG8_SA(0, 0), cA, voffA); PG8_STAGE(PG8_SB(0, 1), cB + hstepB, voffB); PG8_STAGE(PG8_SA(0, 1), cA + hstepA, voffA);
        if (wr == 1) PG8_BAR;
        PG8_WAIT_V(4); PG8_BAR;
        PG8_STAGE(PG8_SB(1, 0), cB + kstep, voffB); PG8_STAGE(PG8_SA(1, 0), cA + kstep, voffA); PG8_STAGE(PG8_SB(1, 1), cB + hstepB + kstep, voffB);
        PG8_WAIT_V(6); PG8_BAR;
    }
    for (;;) {
        const bool has_next = S.next(ui + 1, nxt);
        const char* nA = has_next ? (const char*)g.A + (size_t)nxt.pm * tstepA : cA; const char* nB = has_next ? (const char*)g.Bt + (size_t)nxt.pn * tstepB : cB;
        for (int t = 0; t < nt; t += 2) {
            const bool last = (t == nt - 2);
            const char* a1 = cA + (size_t)(t + 1) * kstep;
            const char* a2 = last ? nA : cA + (size_t)(t + 2) * kstep; const char* b2 = last ? nB : cB + (size_t)(t + 2) * kstep;
            const char* a3 = a2 + kstep; const char* b3 = b2 + kstep;
            if constexpr (SP2) {
            PG8_LDB(B0, 0, 0); PG8_LDB(B1, 0, 1); PG8_SCHED; PG8_LDA(At, 0, 0); PG8_STAGE(PG8_SA(1, 1), a1 + hstepA, voffA);
            PG8_WAIT_V(8); PG8_WAIT_L(0); PG8_BAR; PG8_MMA(0, 0, At, B0); PG8_MMA(0, 1, At, B1); PG8_BAR; PG8_SCHED;
            PG8_LDA(At, 0, 1); PG8_STAGE(PG8_SB(0, 0), b2, voffB); PG8_STAGE(PG8_SB(0, 1), b2 + hstepB, voffB); PG8_STAGE(PG8_SA(0, 0), a2, voffA);
            PG8_WAIT_V(8); PG8_WAIT_L(0); PG8_BAR; PG8_MMA(1, 0, At, B0); PG8_MMA(1, 1, At, B1); PG8_BAR; PG8_SCHED;
            PG8_LDB(B0, 1, 0); PG8_LDB(B1, 1, 1); PG8_SCHED; PG8_LDA(At, 1, 0); PG8_STAGE(PG8_SA(0, 1), a2 + hstepA, voffA);
            PG8_WAIT_V(8); PG8_WAIT_L(0); PG8_BAR; PG8_MMA(0, 0, At, B0); PG8_MMA(0, 1, At, B1); PG8_BAR; PG8_SCHED;
            PG8_LDA(At, 1, 1); PG8_STAGE(PG8_SB(1, 0), b3, voffB); PG8_STAGE(PG8_SB(1, 1), b3 + hstepB, voffB); PG8_STAGE(PG8_SA(1, 0), a3, voffA);
            PG8_WAIT_V(8); PG8_WAIT_L(0); PG8_BAR; PG8_MMA(1, 0, At, B0); PG8_MMA(1, 1, At, B1); PG8_BAR; PG8_SCHED;
            } else {
            PG8_LDB(B0, 0, 0); PG8_SCHED; PG8_LDA(At, 0, 0); PG8_STAGE(PG8_SA(1, 1), a1 + hstepA, voffA);
            PG8_WAIT_L(8); PG8_BAR; PG8_WAIT_L(0); PG8_MMA(0, 0, At, B0); PG8_BAR; PG8_SCHED;
            PG8_LDB(B1, 0, 1); PG8_STAGE(PG8_SB(0, 0), b2, voffB);
            PG8_BAR; PG8_WAIT_L(0); PG8_MMA(0, 1, At, B1); PG8_BAR;
            PG8_LDA(At, 0, 1); PG8_STAGE(PG8_SA(0, 0), a2, voffA);
            PG8_BAR; PG8_WAIT_L(0); PG8_MMA(1, 0, At, B0); PG8_BAR; PG8_SCHED;
            PG8_STAGE(PG8_SB(0, 1), b2 + hstepB, voffB);
            PG8_WAIT_V(6); PG8_BAR; PG8_MMA(1, 1, At, B1); PG8_BAR;
            PG8_LDB(B0, 1, 0); PG8_SCHED; PG8_LDA(At, 1, 0); PG8_STAGE(PG8_SA(0, 1), a2 + hstepA, voffA);
            PG8_WAIT_L(8); PG8_BAR; PG8_WAIT_L(0); PG8_MMA(0, 0, At, B0); PG8_BAR; PG8_SCHED;
            PG8_LDB(B1, 1, 1); PG8_STAGE(PG8_SB(1, 0), b3, voffB);
            PG8_BAR; PG8_WAIT_L(0); PG8_MMA(0, 1, At, B1); PG8_BAR;
            PG8_LDA(At, 1, 1); PG8_STAGE(PG8_SA(1, 0), a3, voffA);
            PG8_BAR; PG8_WAIT_L(0); PG8_MMA(1, 0, At, B0); PG8_BAR; PG8_SCHED;
            PG8_STAGE(PG8_SB(1, 1), b3 + hstepB, voffB);
            PG8_WAIT_V(6); PG8_BAR; PG8_MMA(1, 1, At, B1); PG8_BAR;
            }
        }
        if constexpr (ALIGN_EPI) { if (wr == 0) PG8_BAR; }
        if constexpr (!Epi::AFTER_DRAIN) { E(acc, cur, wr, wc, fr, fq, lds, wid, lane); }
        if (!has_next) break;
#pragma unroll
        for (int a = 0; a < 2; ++a)
#pragma unroll
            for (int b = 0; b < 2; ++b)
#pragma unroll
                for (int m = 0; m < 4; ++m)
#pragma unroll
                    for (int n = 0; n < 2; ++n) acc[a][b][m][n] = (f32x4){0.f, 0.f, 0.f, 0.f};
        cur = nxt; cA = nA; cB = nB; ++ui;
        if constexpr (ALIGN_EPI) { if (wr == 1) PG8_BAR; }
    }
    PG8_WAIT_V(0);
    if constexpr (!ALIGN_EPI) { if (wr == 0) PG8_BAR; }
    PG8_BAR;
    if constexpr (Epi::AFTER_DRAIN) { E.fused(acc, cur, wr, wc, fr, fq, lds, wid, lane); }
#undef PG8_SA
#undef PG8_SB
#undef PG8_STAGE
#undef PG8_LDA
#undef PG8_LDB
#undef PG8_MMA
#undef PG8_WAIT_V
#undef PG8_WAIT_L
#undef PG8_BAR
#undef PG8_SCHED
}
}
typedef __bf16 bf16x2_t __attribute__((ext_vector_type(2)));
__device__ __forceinline__ unsigned cvtpk(float lo, float hi) { f32x2 v = {lo, hi}; bf16x2_t b = __builtin_convertvector(v, bf16x2_t); return __builtin_bit_cast(unsigned, b); }
__device__ __forceinline__ u32x4 pack8(const f32x4 a, const f32x4 b) { u32x4 w; w.x = cvtpk(a[0], a[1]); w.y = cvtpk(a[2], a[3]); w.z = cvtpk(b[0], b[1]); w.w = cvtpk(b[2], b[3]); return w; }
constexpr int XOFF = pg8::STAGE_BYTES;

struct EpiProj {
    static constexpr bool PERM = true, AFTER_DRAIN = false;
    bf16_t* q; float* ckvraw; bf16_t* qidx; bf16_t* u; bf16_t* kidx; float* widx;
    __device__ __forceinline__ void operator()(const f32x4 (&acc)[2][2][4][2], const pg8::Unit& un, int wr, int wc, int fr, int fq, LAS unsigned char*, int, int) const {
        const int pn = un.pn, row0 = un.pm * 256 + wr * 64 + fr;
#pragma unroll
        for (int ai = 0; ai < 2; ++ai)
#pragma unroll
            for (int m = 0; m < 4; ++m) { const size_t r = (size_t)(row0 + ai * 128 + m * 16);
#pragma unroll
                for (int bj = 0; bj < 2; ++bj) { const int c = bj * 128 + wc * 32 + 8 * fq; const f32x4 v0 = acc[ai][bj][m][0], v1 = acc[ai][bj][m][1];
                    if (pn < 4) *(u32x4*)(q + r * 1024 + pn * 256 + c) = pack8(v0, v1);
                    else if (pn == 4) { *(f32x4*)(ckvraw + r * CKV + c) = v0; *(f32x4*)(ckvraw + r * CKV + c + 4) = v1; }
                    else if (pn < 9) *(u32x4*)(qidx + r * 1024 + (pn - 5) * 256 + c) = pack8(v0 * 0.125f, v1 * 0.125f);
                    else if (pn < 13) *(u32x4*)(u + r * 1024 + (pn - 9) * 256 + c) = pack8(v0, v1);
                    else { if (c < 64) *(u32x4*)(kidx + r * IDIM + c) = pack8(v0, v1);
                           else if (c < 80) { *(f32x4*)(widx + r * IH + (c - 64)) = v0 * 0.25f; *(f32x4*)(widx + r * IH + (c - 64) + 4) = v1 * 0.25f; } } } }
    }
};
struct EpiBf16P {
    static constexpr bool PERM = true, AFTER_DRAIN = false;
    bf16_t* C; int ldc;
    __device__ __forceinline__ void operator()(const f32x4 (&acc)[2][2][4][2], const pg8::Unit& un, int wr, int wc, int fr, int fq, LAS unsigned char*, int, int) const {
        const int row0 = un.pm * 256 + wr * 64 + fr;
#pragma unroll
        for (int ai = 0; ai < 2; ++ai)
#pragma unroll
            for (int m = 0; m < 4; ++m) { const size_t r = (size_t)(row0 + ai * 128 + m * 16);
#pragma unroll
                for (int bj = 0; bj < 2; ++bj) { const int c = un.pn * 256 + bj * 128 + wc * 32 + 8 * fq;
                    *(u32x4*)(C + r * ldc + c) = pack8(acc[ai][bj][m][0], acc[ai][bj][m][1]); } }
    }
};
struct EpiPre {
    static constexpr bool PERM = false, AFTER_DRAIN = false;
    const float* base; float* out; int ldc;
    __device__ __forceinline__ void operator()(const f32x4 (&acc)[2][2][4][2], const pg8::Unit& un, int wr, int wc, int fr, int fq, LAS unsigned char*, int, int) const {
        const int row0 = un.pm * 256 + wr * 64 + fr, col0 = un.pn * 256 + wc * 32 + 4 * fq;
#pragma unroll
        for (int ai = 0; ai < 2; ++ai)
#pragma unroll
            for (int m = 0; m < 4; ++m) { const size_t off = (size_t)(row0 + ai * 128 + m * 16) * ldc + col0;
#pragma unroll
                for (int bj = 0; bj < 2; ++bj)
#pragma unroll
                    for (int n = 0; n < 2; ++n) { const f32x4 bs = *(const f32x4*)(base + off + bj * 128 + n * 16); *(f32x4*)(out + off + bj * 128 + n * 16) = bs * ALPHA + acc[ai][bj][m][n]; } }
    }
};
__device__ __forceinline__ float gelu_tanh(float x) {
    const float t = x * x * 0.044715f + 1.0f; const float e = __builtin_amdgcn_exp2f(-2.302208198f * x * t); return x * __builtin_amdgcn_rcpf(1.0f + e); }
template <int CTRL> __device__ __forceinline__ float dpp0(float v) { return __builtin_bit_cast(float, __builtin_amdgcn_update_dpp(0, __builtin_bit_cast(int, v), CTRL, 0xf, 0xf, true)); }
__device__ __forceinline__ f32x4 shfl4(const f32x4 v, int src) { f32x4 r; r[0] = __shfl(v[0], src); r[1] = __shfl(v[1], src); r[2] = __shfl(v[2], src); r[3] = __shfl(v[3], src); return r; }
struct EpiConv {
    static constexpr bool PERM = true, AFTER_DRAIN = false;
    bf16_t* act; float* head; float* tail; const float* cw; const float* cb;
    __device__ __forceinline__ void operator()(const f32x4 (&acc)[2][2][4][2], const pg8::Unit& un, int wr, int wc, int fr, int fq, LAS unsigned char* lds, int, int lane) const {
        LAS float* X = (LAS float*)(lds + XOFF);
        const int colb = wc * 32 + 8 * fq, pm = un.pm, pn = un.pn;
        if (wr == 0 && fr < 2) {
#pragma unroll
            for (int bj = 0; bj < 2; ++bj)
#pragma unroll
                for (int n = 0; n < 2; ++n) *(f32x4*)(head + ((size_t)pm * 2 + fr) * (2 * D_FF) + pn * 256 + bj * 128 + colb + 4 * n) = acc[0][bj][0][n]; }
        if (wr == 1 && fr >= 14) {
#pragma unroll
            for (int bj = 0; bj < 2; ++bj)
#pragma unroll
                for (int n = 0; n < 2; ++n) *(f32x4*)(tail + ((size_t)pm * 2 + (fr - 14)) * (2 * D_FF) + pn * 256 + bj * 128 + colb + 4 * n) = acc[1][bj][3][n]; }
        if (fr >= 14) {
#pragma unroll
            for (int ai = 0; ai < 2; ++ai)
#pragma unroll
                for (int bj = 0; bj < 2; ++bj)
#pragma unroll
                    for (int n = 0; n < 2; ++n) *(LAS f32x4*)(X + ((2 * ai + wr) * 2 + (fr - 14)) * 256 + bj * 128 + colb + 4 * n) = acc[ai][bj][3][n]; }
        asm volatile("s_waitcnt lgkmcnt(0)" ::: "memory"); __builtin_amdgcn_s_barrier(); asm volatile("" ::: "memory");
        const int colA = pn * 128 + colb;
        u32x2 stash[2][4];
#pragma unroll
        for (int n = 0; n < 2; ++n) {
            f32x4 w[2][3], bb[2];
#pragma unroll
            for (int p = 0; p < 2; ++p) { bb[p] = *(const f32x4*)(cb + p * D_FF + colA + 4 * n);
#pragma unroll
                for (int j = 0; j < 3; ++j) w[p][j] = *(const f32x4*)(cw + (size_t)j * (2 * D_FF) + p * D_FF + colA + 4 * n); }
#pragma unroll
            for (int ai = 0; ai < 2; ++ai)
#pragma unroll
                for (int m = 0; m < 4; ++m) {
                    const int chunk = 2 * ai + wr;
                    f32x4 cv[2];
#pragma unroll
                    for (int p = 0; p < 2; ++p) {
                        const f32x4 cur = acc[ai][p][m][n];
                        f32x4 o = cur * w[p][2] + bb[p];
#pragma unroll
                        for (int e = 0; e < 4; ++e) { o[e] = fmaf(dpp0<0x111>(cur[e]), w[p][1][e], o[e]); o[e] = fmaf(dpp0<0x112>(cur[e]), w[p][0][e], o[e]); }
                        if (m > 0) { const f32x4 pg = acc[ai][p][m - 1][n];
#pragma unroll
                            for (int e = 0; e < 4; ++e) { o[e] = fmaf(dpp0<0x10F>(pg[e]), w[p][1][e], o[e]); o[e] = fmaf(dpp0<0x10E>(pg[e]), w[p][0][e], o[e]); } }
                        else { const int pc = chunk > 0 ? chunk - 1 : 0;
                            f32x4 x1 = *(const LAS f32x4*)(X + (pc * 2 + 1) * 256 + p * 128 + colb + 4 * n);
                            f32x4 x2 = *(const LAS f32x4*)(X + (pc * 2 + (fr & 1)) * 256 + p * 128 + colb + 4 * n);
                            const float s1 = fr == 0 ? 1.f : 0.f, s2 = fr < 2 ? 1.f : 0.f;
                            o = o + (x1 * s1) * w[p][1] + (x2 * s2) * w[p][0]; }
                        asm volatile("" : "+v"(o));
                        cv[p] = o;
                    }
                    f32x4 o;
#pragma unroll
                    for (int e = 0; e < 4; ++e) o[e] = gelu_tanh(cv[0][e]) * cv[1][e];
                    u32x2 pkd = (u32x2){cvtpk(o[0], o[1]), cvtpk(o[2], o[3])};
                    asm volatile("" : "+v"(pkd));
                    if (n == 0) stash[ai][m] = pkd;
                    else { const bool valid = !(chunk == 0 && m == 0 && fr < 2);
                        if (valid) *(u32x4*)(act + (size_t)(pm * 256 + ai * 128 + wr * 64 + m * 16 + fr) * D_FF + colA) = (u32x4){stash[ai][m].x, stash[ai][m].y, pkd.x, pkd.y}; }
                    __builtin_amdgcn_sched_barrier(0);
                }
        }
    }
};
#define XB_TMO      128
#define XB_XCNT(j)  (256  + 64 * (j))
#define XB_XSUB(j)  (1280 + 64 * (j))
#define XB_XGEN(j)  (2304 + 64 * (j))
#define XB_TOP      3328
#define XB_TOPGEN   3392
#define XCD_BAR_WORDS 3456
#define XB_SPIN_CAP (1u << 22)
__device__ __forceinline__ unsigned xb_ld(unsigned* p)              { return __hip_atomic_load(p, __ATOMIC_RELAXED, __HIP_MEMORY_SCOPE_AGENT); }
__device__ __forceinline__ unsigned xb_add(unsigned* p, unsigned v) { return __hip_atomic_fetch_add(p, v, __ATOMIC_RELAXED, __HIP_MEMORY_SCOPE_AGENT); }
__device__ __forceinline__ unsigned xb_xcc_id() { return (unsigned)__builtin_amdgcn_s_getreg((3 << 11) | 20) & 0xFu; }
#define XB_SPIN(cond, bar) do { unsigned _sp = 0; while (cond) { __builtin_amdgcn_s_sleep(1); \
    if ((++_sp & 255u) == 0u) { if (xb_ld(&(bar)[XB_TMO])) break; if (_sp > XB_SPIN_CAP) { atomicAdd(&(bar)[XB_TMO], 1u); break; } } } } while (0)
struct XcdBarrier { unsigned* bar; unsigned x; volatile LAS unsigned* st; };
__device__ __forceinline__ XcdBarrier xcd_barrier_post(unsigned* bar, volatile LAS unsigned* st) {
    XcdBarrier b; b.bar = bar; b.x = xb_xcc_id(); b.st = st;
    if (threadIdx.x == 0) (void)xb_add(&bar[XB_XCNT(b.x)], 1u);
    return b;
}
__device__ __forceinline__ void xcd_barrier_complete(unsigned* bar, unsigned x, unsigned& nloc, unsigned& nx) {
    const unsigned G = gridDim.x * gridDim.y * gridDim.z;
    unsigned sum, cnt, mine, sp = 0u;
    for (;;) {
        sum = 0u; cnt = 0u; mine = 0u;
#pragma unroll
        for (unsigned j = 0; j < 16; ++j) { const unsigned c = xb_ld(&bar[XB_XCNT(j)]); sum += c; cnt += (c > 0u) ? 1u : 0u; mine = (j == x) ? c : mine; }
        if (sum == G) break;
        __builtin_amdgcn_s_sleep(1);
        if ((++sp & 255u) == 0u) { if (xb_ld(&bar[XB_TMO])) break; if (sp > XB_SPIN_CAP) { atomicAdd(&bar[XB_TMO], 1u); break; } }
    }
    nloc = mine > 0u ? mine : 1u; nx = cnt > 0u ? cnt : 1u;
}
__device__ __forceinline__ void xcd_barrier(const XcdBarrier& b) {
    asm volatile("s_waitcnt vmcnt(0)" ::: "memory");
    __syncthreads();
    if (threadIdx.x == 0) {
        unsigned* bar = b.bar;
        __builtin_amdgcn_s_waitcnt(0);
        unsigned nloc = b.st[0], nx = b.st[1];
        if (nloc == 0u) { xcd_barrier_complete(bar, b.x, nloc, nx); b.st[0] = nloc; b.st[1] = nx; }
        const unsigned old = xb_add(&bar[XB_XSUB(b.x)], 1u);
        const unsigned gen = old / nloc;
        if (old + 1u == (gen + 1u) * nloc) {
            __builtin_amdgcn_fence(__ATOMIC_RELEASE, "agent");
            asm volatile("s_waitcnt vmcnt(0)" ::: "memory");
            const unsigned og = xb_add(&bar[XB_TOP], 1u);
            const unsigned tg = og / nx;
            if (og + 1u == (tg + 1u) * nx) xb_add(&bar[XB_TOPGEN], 1u);
            else XB_SPIN(xb_ld(&bar[XB_TOPGEN]) == tg, bar);
            __builtin_amdgcn_fence(__ATOMIC_ACQUIRE, "agent");
            xb_add(&bar[XB_XGEN(b.x)], 1u);
            asm volatile("s_waitcnt vmcnt(0)" ::: "memory");
        } else {
            XB_SPIN(xb_ld(&bar[XB_XGEN(b.x)]) == gen, bar);
            __builtin_amdgcn_fence(__ATOMIC_ACQUIRE, "agent");
            asm volatile("s_waitcnt vmcnt(0)" ::: "memory");
        }
    }
    __syncthreads();
}

constexpr size_t al(size_t x) { return (x + 4095) & ~(size_t)4095; }
constexpr size_t O_CTL = 0, CTL_BYTES = 65536;
constexpr size_t O_WIN = O_CTL + CTL_BYTES;
constexpr size_t O_WOT = O_WIN + al((size_t)PROJ_PAD * D_MODEL * 2);
constexpr size_t O_WOF = O_WOT + al((size_t)D_MODEL * D_MODEL * 2);
constexpr size_t O_WUP = O_WOF + al((size_t)D_MODEL * D_MODEL * 2);
constexpr size_t O_WDN = O_WUP + al((size_t)2 * D_FF * D_MODEL * 2);
constexpr size_t O_WUK = O_WDN + al((size_t)D_MODEL * D_FF * 2);
constexpr size_t O_WUVT = O_WUK + al((size_t)CKV * 1024 * 2);
constexpr size_t O_WPS = O_WUVT + al((size_t)1024 * CKV * 2);
constexpr size_t O_CKV = O_WPS + al((size_t)4 * PG * PG * 2);
constexpr size_t O_KIDX = O_CKV + al((size_t)RP * CKV * 2);
constexpr size_t O_WIDX = O_KIDX + al((size_t)RP * IDIM * 2);
constexpr size_t O_MASK = O_WIDX + al((size_t)RP * IH * 4);
constexpr size_t O_CAT = O_MASK + al((size_t)RP * MW * 4);
constexpr size_t O_H1 = O_CAT + al((size_t)RP * D_MODEL * 2);
constexpr size_t O_H1B = O_H1 + al((size_t)RREAL * D_MODEL * 4);
constexpr size_t O_HALO = O_H1B + al((size_t)RREAL * D_MODEL * 2);
constexpr size_t HALO_HEAD = 0, HALO_TAIL = (size_t)64 * 2 * D_FF * 4, HALO_ZMETA = 2 * HALO_TAIL, HALO_PREM = HALO_ZMETA + (size_t)2 * 2 * D_FF * 4, HALO_H1M = HALO_PREM + 2 * D_MODEL * 4, HALO_BYTES = HALO_H1M + 2 * D_MODEL * 4;
constexpr size_t O_X = O_HALO + al(HALO_BYTES);
constexpr size_t O_HB = O_X;
constexpr size_t O_Q = O_HB + al((size_t)RP * D_MODEL * 2);
constexpr size_t O_QIDX = O_Q + al((size_t)RP * 1024 * 2);
constexpr size_t O_U = O_QIDX + al((size_t)RP * 1024 * 2);
constexpr size_t O_CKVRAW = O_U + al((size_t)RP * 1024 * 2);
constexpr size_t O_SC = O_H1;
static_assert((size_t)BATCH * T * SCP * 4 <= (size_t)RREAL * D_MODEL * 6, "scores fit");
constexpr size_t O_ACT = O_X;
constexpr size_t X_END_A = O_CKVRAW + al((size_t)RP * CKV * 4), X_END_B = O_ACT + al((size_t)RREAL * D_FF * 2);
constexpr size_t WS_NEED = X_END_A > X_END_B ? X_END_A : X_END_B;
static_assert(WS_NEED <= (size_t)352 * 1024 * 1024, "workspace budget");
constexpr int CW_BAR = 0, CW_Q2 = 8192;

constexpr int LDS_BYTES = 163840;
constexpr int MISC_OFF = LDS_BYTES - 256;

__device__ __forceinline__ int swap23(int p) { return (p & ~0xC) | ((p & 4) << 1) | ((p & 8) >> 1); }
template <bool KSWAP, class DR>
__device__ __forceinline__ void p0_transpose_item(const float* __restrict__ W, int K, int N, bf16_t* WT, int ldwt, const DR& dr, bf16_t* WT2, int k2lim, LAS float* scr, int item, int lane) {
    const int nblk = (N + 31) / 32, kb = item / nblk, nb = item % nblk, k0 = 64 * kb, n0 = 32 * nb;
    const int ncol = n0 + (lane & 31);
#pragma unroll 8
    for (int i = 0; i < 32; ++i) { const int kk = 2 * i + (lane >> 5); scr[kk * 33 + (lane & 31)] = ncol < N ? W[(size_t)(k0 + kk) * N + ncol] : 0.f; }
    asm volatile("s_waitcnt lgkmcnt(0)" ::: "memory");
    const int c = lane & 7;
#pragma unroll
    for (int j = 0; j < 4; ++j) { const int nl = (lane >> 3) + 8 * j, n = n0 + nl;
        float s[8];
#pragma unroll
        for (int e = 0; e < 8; ++e) { const int p = 8 * c + e; s[e] = scr[(KSWAP ? swap23(p) : p) * 33 + nl]; }
        u32x4 o; o.x = pk2(s[0], s[1]); o.y = pk2(s[2], s[3]); o.z = pk2(s[4], s[5]); o.w = pk2(s[6], s[7]);
        if (n < N) { const size_t row = (size_t)dr(n); *(u32x4*)(WT + row * ldwt + k0 + 8 * c) = o; if (WT2 && k0 < k2lim) *(u32x4*)(WT2 + row * ldwt + k0 + 8 * c) = o; } }
    asm volatile("s_waitcnt lgkmcnt(0)" ::: "memory");
}
struct DrId { __device__ __forceinline__ int operator()(int n) const { return n; } };
struct DrWin { __device__ __forceinline__ int operator()(int n) const {
    return n < 2304 ? n : (n < 2368 ? 3328 + (n - 2304) : (n < 2384 ? 3392 + (n - 2368) : 2304 + (n - 2384))); } };
struct DrWup { __device__ __forceinline__ int operator()(int n) const { const int p = n >= D_FF, m = n - p * D_FF; return (m >> 7) * 256 + p * 128 + (m & 127); } };

struct Ptrs {
    const float *x, *meta, *relb, *w_in, *kvg, *w_uk, *w_uv, *w_pool, *pscale, *w_o, *ln1g, *ln1b, *w_up, *convw, *convb, *w_dn, *ln2g, *ln2b; float* out; char* ws;
};

__device__ __forceinline__ void p0_prologue(const Ptrs& P, LAS unsigned char* lds, int wave, int lane, int G) {
    char* ws = P.ws;
    bf16_t *WinT = (bf16_t*)(ws + O_WIN), *WoT = (bf16_t*)(ws + O_WOT), *WoF = (bf16_t*)(ws + O_WOF), *WupT = (bf16_t*)(ws + O_WUP), *WdnT = (bf16_t*)(ws + O_WDN);
    bf16_t *wukb = (bf16_t*)(ws + O_WUK), *wuvT = (bf16_t*)(ws + O_WUVT), *wps = (bf16_t*)(ws + O_WPS), *hb = (bf16_t*)(ws + O_HB);
    LAS float* scr = (LAS float*)(lds + wave * 16384);
    const int gw = blockIdx.x * 8 + wave, NGW = G * 8;
    constexpr int I_IN = (D_MODEL / 64) * ((PROJ + 31) / 32), I_O = (D_MODEL / 64) * (D_MODEL / 32), I_UP = (D_MODEL / 64) * (2 * D_FF / 32), I_DN = (D_FF / 64) * (D_MODEL / 32), I_UV = (CKV / 64) * (1024 / 32);
    constexpr int NITEMS = I_IN + I_O + I_UP + I_DN + I_UV;
    for (int it = gw; it < NITEMS; it += NGW) {
        int r = it;
        if (r < I_UP) { p0_transpose_item<false>(P.w_up, D_MODEL, 2 * D_FF, WupT, D_MODEL, DrWup{}, nullptr, 0, scr, r, lane); continue; } r -= I_UP;
        if (r < I_DN) { p0_transpose_item<false>(P.w_dn, D_FF, D_MODEL, WdnT, D_FF, DrId{}, nullptr, 0, scr, r, lane); continue; } r -= I_DN;
        if (r < I_IN) { p0_transpose_item<false>(P.w_in, D_MODEL, PROJ, WinT, D_MODEL, DrWin{}, nullptr, 0, scr, r, lane); continue; } r -= I_IN;
        if (r < I_O) { p0_transpose_item<false>(P.w_o, D_MODEL, D_MODEL, WoT, D_MODEL, DrId{}, WoF, 1024, scr, r, lane); continue; } r -= I_O;
        p0_transpose_item<true>(P.w_uv, CKV, 1024, wuvT, CKV, DrId{}, nullptr, 0, scr, r, lane);
    }
    for (int i = gw * 64 + lane; i < (PROJ_PAD - PROJ) * D_MODEL / 8; i += NGW * 64) *(u32x4*)(WinT + (size_t)PROJ * D_MODEL + (size_t)i * 8) = (u32x4){0u, 0u, 0u, 0u};
    for (int i = gw * 64 + lane; i < CKV * 1024 / 4; i += NGW * 64) { const f32x4 v = *(const f32x4*)(P.w_uk + (size_t)i * 4); *(u32x2*)(wukb + (size_t)i * 4) = (u32x2){pk2(v[0], v[1]), pk2(v[2], v[3])}; }
    for (int i = gw * 64 + lane; i < 4 * PG * PG / 4; i += NGW * 64) { const f32x4 v = *(const f32x4*)(P.w_pool + (size_t)i * 4); const int e = i * 4, g = e / (PG * PG), j = e % PG;
        const f32x4 s = *(const f32x4*)(P.pscale + g * PG + j); *(u32x2*)(wps + (size_t)e) = (u32x2){pk2(v[0] * s[0], v[1] * s[1]), pk2(v[2] * s[2], v[3] * s[3])}; }
    for (int row = gw; row < RP; row += NGW) {
        const float* src = row < RREAL ? P.x + (size_t)row * D_MODEL : (row < R ? P.meta + (size_t)(row - RREAL) * D_MODEL : nullptr);
#pragma unroll
        for (int j = 0; j < 8; ++j) { const int c = 4 * lane + 256 * j; f32x4 v = (f32x4){0.f, 0.f, 0.f, 0.f}; if (src) v = *(const f32x4*)(src + c);
            *(u32x2*)(hb + (size_t)row * D_MODEL + c) = (u32x2){pk2(v[0], v[1]), pk2(v[2], v[3])}; }
    }
}
__device__ __forceinline__ void rmsnorm_row(const float* __restrict__ raw, const float* __restrict__ g, bf16_t* __restrict__ ckv, int row, int lane) {
    const f32x4 v = *(const f32x4*)(raw + (size_t)row * CKV + lane * 4);
    float s = v[0] * v[0] + v[1] * v[1] + v[2] * v[2] + v[3] * v[3];
#pragma unroll
    for (int o = 1; o < 64; o <<= 1) s += __shfl_xor(s, o);
    const float r = 1.0f / sqrtf(s * (1.0f / CKV) + LN_EPS);
    const f32x4 gg = *(const f32x4*)(g + lane * 4);
    *(u32x2*)(ckv + (size_t)row * CKV + lane * 4) = (u32x2){pk2(v[0] * r * gg[0], v[1] * r * gg[1]), pk2(v[2] * r * gg[2], v[3] * r * gg[3])};
}
__device__ __forceinline__ void nv_scores(const bf16_t* __restrict__ qidx, const bf16_t* __restrict__ kidx, const float* __restrict__ widx, float* __restrict__ sc, int b, int t, LAS unsigned char* lds) {
    LAS float* sq = (LAS float*)lds; LAS float* sw = sq + IH * IDIM;
    const int rq = rid(b, t), tid = threadIdx.x;
    __syncthreads();
    for (int i = tid; i < IH * IDIM; i += 512) sq[i] = bf2f(qidx[(size_t)rq * 1024 + i]);
    if (tid < IH) sw[tid] = widx[(size_t)rq * IH + tid];
    __syncthreads();
    for (int s = tid; s <= t; s += 512) {
        const bf16_t* kp = kidx + (size_t)rid(b, s) * IDIM; float k[IDIM];
#pragma unroll
        for (int i = 0; i < IDIM; i += 8) { const u32x4 w = *(const u32x4*)(kp + i);
            k[i] = bflo(w.x); k[i + 1] = bfhi(w.x); k[i + 2] = bflo(w.y); k[i + 3] = bfhi(w.y); k[i + 4] = bflo(w.z); k[i + 5] = bfhi(w.z); k[i + 6] = bflo(w.w); k[i + 7] = bfhi(w.w); }
        float score = 0.f;
        for (int h = 0; h < IH; ++h) { float d = 0.f;
#pragma unroll
            for (int i = 0; i < IDIM; ++i) d = fmaf(sq[h * IDIM + i], k[i], d);
            score = fmaf(sw[h], fmaxf(d, 0.f), score); }
        sc[((size_t)b * T + t) * SCP + s] = score;
    }
}
__device__ __forceinline__ unsigned fkey(float f) { const unsigned u = __builtin_bit_cast(unsigned, f); return (u & 0x80000000u) ? ~u : (u | 0x80000000u); }
__device__ __forceinline__ void topk_emit(unsigned (&key)[33], int t, unsigned* mrow, int lane) {
    constexpr int NI = 33;
    if (t + 1 <= TOPK) {
#pragma unroll
        for (int i = 0; i < NI; ++i) { const int s = i * 64 + lane; const unsigned long long m = __ballot(s <= t);
            if (lane == 0) { mrow[2 * i] = (unsigned)m; mrow[2 * i + 1] = (unsigned)(m >> 32); } }
        if (lane < MW - 2 * NI) mrow[2 * NI + lane] = 0u;
        return;
    }
    unsigned thr = 0u;
    for (int bit = 31; bit >= 0; --bit) {
        const unsigned cand = thr | (1u << bit); int c = 0;
#pragma unroll
        for (int i = 0; i < NI; ++i) c += (key[i] >= cand) ? 1 : 0;
#pragma unroll
        for (int o = 1; o < 64; o <<= 1) c += __shfl_xor(c, o);
        if (c >= TOPK) thr = cand;
    }
    int cgt = 0;
#pragma unroll
    for (int i = 0; i < NI; ++i) cgt += (key[i] > thr) ? 1 : 0;
#pragma unroll
    for (int o = 1; o < 64; o <<= 1) cgt += __shfl_xor(cgt, o);
    int need = TOPK - cgt;
#pragma unroll
    for (int i = 0; i < NI; ++i) {
        const bool eq = key[i] == thr; const unsigned long long em = __ballot(eq);
        const int before = __popcll(em & ((1ull << lane) - 1ull));
        const bool sel = (key[i] > thr) || (eq && before < need);
        need -= __popcll(em); if (need < 0) need = 0;
        const unsigned long long m = __ballot(sel);
        if (lane == 0) { mrow[2 * i] = (unsigned)m; mrow[2 * i + 1] = (unsigned)(m >> 32); }
    }
    if (lane < MW - 2 * NI) mrow[2 * NI + lane] = 0u;
}
__device__ __forceinline__ void nv_topk_row(const float* __restrict__ sc, unsigned* __restrict__ mask, int b, int t, int lane) {
    unsigned key[33]; const float* srow = sc + ((size_t)b * T + t) * SCP;
#pragma unroll
    for (int i = 0; i < 33; ++i) { const int s = i * 64 + lane; key[i] = (s <= t && t + 1 > TOPK) ? fkey(srow[s]) : 0u; }
    topk_emit(key, t, mask + (size_t)rid(b, t) * MW, lane);
}
__device__ __forceinline__ void nv_pooldiff(const bf16_t* __restrict__ u, bf16_t* __restrict__ cat, int b, int t) {
    for (int c = threadIdx.x; c < POOLW; c += 512) {
        const int w = 2 << (c / PG); const int cntw = (t + 1) < w ? (t + 1) : w; float s = 0.f;
        for (int i = cntw - 1; i >= 0; --i) s += bf2f(u[(size_t)rid(b, t - i) * POOLW + c]);
        const float cur = bf2f(u[(size_t)rid(b, t) * POOLW + c]);
        cat[(size_t)rid(b, t) * D_MODEL + 1024 + c] = (bf16_t)f2bf(s / (float)cntw - cur);
    }
}
__device__ __forceinline__ void nv_attn(const bf16_t* __restrict__ q, const bf16_t* __restrict__ wukb, const bf16_t* __restrict__ wuvT, const bf16_t* __restrict__ ckv,
                                        const unsigned* __restrict__ mask, const float* __restrict__ relb, bf16_t* __restrict__ cat, int b, int t, LAS unsigned char* lds, int tid) {
    LAS float* sqa = (LAS float*)lds;
    LAS float* sp = sqa + NH * CKV;
    LAS float* so = sp + NH * TOPK;
    LAS float* qrow = so + NH * CKV;
    LAS float* red = qrow + 1024;
    LAS int* sel = (LAS int*)(red + 32);
    LAS int* woff = sel + TOPK;
    const int rq = rid(b, t), lane = tid & 63, wid = tid >> 6;
    const unsigned* mrow = mask + (size_t)rq * MW;
    __syncthreads();
    for (int i = tid; i < 1024; i += 512) qrow[i] = bf2f(q[(size_t)rq * 1024 + i]);
    if (tid < 65) woff[tid] = __popc(mrow[tid]);
    __syncthreads();
    if (tid == 0) { int a = 0; for (int i = 0; i < 65; ++i) { const int c = woff[i]; woff[i] = a; a += c; } woff[65] = a; }
    __syncthreads();
    if (tid < 65) { unsigned w = mrow[tid]; int p = woff[tid]; while (w) { const int bit = __ffs((int)w) - 1; w &= w - 1; if (p < TOPK) sel[p] = tid * 32 + bit; ++p; } }
    for (int o = tid; o < NH * CKV; o += 512) { const int h = o >> 8, c = o & 255; const bf16_t* wp = wukb + (size_t)c * 1024 + h * HD; float a = 0.f;
        for (int d = 0; d < HD; d += 8) { const u32x4 w = *(const u32x4*)(wp + d); const LAS float* qp = qrow + h * HD + d;
            a = fmaf(qp[0], bflo(w.x), a); a = fmaf(qp[1], bfhi(w.x), a); a = fmaf(qp[2], bflo(w.y), a); a = fmaf(qp[3], bfhi(w.y), a);
            a = fmaf(qp[4], bflo(w.z), a); a = fmaf(qp[5], bfhi(w.z), a); a = fmaf(qp[6], bflo(w.w), a); a = fmaf(qp[7], bfhi(w.w), a); }
        sqa[o] = bf2f((bf16_t)f2bf(a)); }
    __syncthreads();
    const int ns = woff[65] < TOPK ? woff[65] : TOPK;
    const int k = tid & 255, hh = tid >> 8;
    const int s = k < ns ? sel[k] : 0; const bf16_t* kp = ckv + (size_t)rid(b, s) * CKV;
    float lg[4] = {0.f, 0.f, 0.f, 0.f};
    for (int c = 0; c < CKV; c += 8) { const u32x4 w = *(const u32x4*)(kp + c); float kv[8];
        kv[0] = bflo(w.x); kv[1] = bfhi(w.x); kv[2] = bflo(w.y); kv[3] = bfhi(w.y); kv[4] = bflo(w.z); kv[5] = bfhi(w.z); kv[6] = bflo(w.w); kv[7] = bfhi(w.w);
#pragma unroll
        for (int i = 0; i < 4; ++i)
#pragma unroll
            for (int j = 0; j < 8; ++j) lg[i] = fmaf(sqa[(hh * 4 + i) * CKV + c + j], kv[j], lg[i]); }
    int dist = t - s; if (dist < 0) dist = 0; const int bk = dist < 128 ? T5_BUCKET[dist] : 31;
#pragma unroll
    for (int i = 0; i < 4; ++i) { const int h = hh * 4 + i;
        const float x = k < ns ? lg[i] * 0.08838834764831845f + relb[bk * NH + h] : -INFINITY;
        float m = x;
#pragma unroll
        for (int o = 1; o < 64; o <<= 1) m = fmaxf(m, __shfl_xor(m, o));
        if (lane == 0) red[wid] = m; __syncthreads();
        m = fmaxf(fmaxf(red[hh * 4], red[hh * 4 + 1]), fmaxf(red[hh * 4 + 2], red[hh * 4 + 3])); __syncthreads();
        const float e = k < ns ? __expf(x - m) : 0.f; float sum = e;
#pragma unroll
        for (int o = 1; o < 64; o <<= 1) sum += __shfl_xor(sum, o);
        if (lane == 0) red[16 + wid] = sum; __syncthreads();
        sum = (red[16 + hh * 4] + red[16 + hh * 4 + 1]) + (red[16 + hh * 4 + 2] + red[16 + hh * 4 + 3]);
        sp[h * TOPK + k] = bf2f((bf16_t)f2bf(e / sum)); __syncthreads(); }
    { float o[4] = {0.f, 0.f, 0.f, 0.f}; const int c = k;
      for (int kk = 0; kk < ns; ++kk) { const float v = bf2f(ckv[(size_t)rid(b, sel[kk]) * CKV + c]);
#pragma unroll
          for (int i = 0; i < 4; ++i) o[i] = fmaf(sp[(hh * 4 + i) * TOPK + kk], v, o[i]); }
#pragma unroll
      for (int i = 0; i < 4; ++i) so[(hh * 4 + i) * CKV + c] = bf2f((bf16_t)f2bf(o[i])); }
    __syncthreads();
    for (int n = tid; n < 1024; n += 512) { const int h = n >> 7; const bf16_t* wp = wuvT + (size_t)n * CKV; float a = 0.f;
        for (int p = 0; p < CKV; p += 8) { const u32x4 w = *(const u32x4*)(wp + p); const LAS float* op = so + h * CKV;
            a = fmaf(op[swap23(p + 0)], bflo(w.x), a); a = fmaf(op[swap23(p + 1)], bfhi(w.x), a); a = fmaf(op[swap23(p + 2)], bflo(w.y), a); a = fmaf(op[swap23(p + 3)], bfhi(w.y), a);
            a = fmaf(op[swap23(p + 4)], bflo(w.z), a); a = fmaf(op[swap23(p + 5)], bfhi(w.z), a); a = fmaf(op[swap23(p + 6)], bflo(w.w), a); a = fmaf(op[swap23(p + 7)], bfhi(w.w), a); }
        cat[(size_t)rq * D_MODEL + n] = (bf16_t)f2bf(a); }
}
__device__ __forceinline__ void ln_row(const float* __restrict__ pre, const float* __restrict__ g, const float* __restrict__ bb, float* of32, bf16_t* obf, int lane) {
    f32x4 v[8]; float s = 0.f;
#pragma unroll
    for (int j = 0; j < 8; ++j) { v[j] = *(const f32x4*)(pre + 4 * lane + 256 * j); s += (v[j][0] + v[j][1]) + (v[j][2] + v[j][3]); }
#pragma unroll
    for (int o = 1; o < 64; o <<= 1) s += __shfl_xor(s, o);
    const float mean = s * (1.0f / D_MODEL); float q = 0.f;
#pragma unroll
    for (int j = 0; j < 8; ++j) { v[j] = v[j] - mean; q += (v[j][0] * v[j][0] + v[j][1] * v[j][1]) + (v[j][2] * v[j][2] + v[j][3] * v[j][3]); }
#pragma unroll
    for (int o = 1; o < 64; o <<= 1) q += __shfl_xor(q, o);
    const float rstd = 1.0f / sqrtf(q * (1.0f / D_MODEL) + LN_EPS);
#pragma unroll
    for (int j = 0; j < 8; ++j) { const int c = 4 * lane + 256 * j; const f32x4 gg = *(const f32x4*)(g + c), be = *(const f32x4*)(bb + c); const f32x4 o = v[j] * rstd * gg + be;
        if (of32) *(f32x4*)(of32 + c) = o;
        if (obf) *(u32x2*)(obf + c) = (u32x2){pk2(o[0], o[1]), pk2(o[2], o[3])}; }
}
__device__ __forceinline__ float dot2048(const bf16_t* __restrict__ a, const bf16_t* __restrict__ b, int lane) {
    float s = 0.f;
#pragma unroll
    for (int j = 0; j < 4; ++j) { const u32x4 x = *(const u32x4*)(a + lane * 8 + 512 * j), y = *(const u32x4*)(b + lane * 8 + 512 * j);
        s = fmaf(bflo(x.x), bflo(y.x), s); s = fmaf(bfhi(x.x), bfhi(y.x), s); s = fmaf(bflo(x.y), bflo(y.y), s); s = fmaf(bfhi(x.y), bfhi(y.y), s);
        s = fmaf(bflo(x.z), bflo(y.z), s); s = fmaf(bfhi(x.z), bfhi(y.z), s); s = fmaf(bflo(x.w), bflo(y.w), s); s = fmaf(bfhi(x.w), bfhi(y.w), s); }
#pragma unroll
    for (int o = 1; o < 64; o <<= 1) s += __shfl_xor(s, o);
    return s;
}
constexpr int SPITCH = 2084;
__device__ __forceinline__ void idx_unit(const bf16_t* __restrict__ qidx, const bf16_t* __restrict__ kidx, const float* __restrict__ widx, unsigned* __restrict__ mask,
                                         int b, int g, LAS unsigned char* lds, int wave, int lane) {
    LAS float* S = (LAS float*)lds;
    const int qi = lane & 15, quad = lane >> 4, t = 16 * g + qi, tmax = 16 * g + 15;
    if (tmax >= TOPK) {
        const int rq = rid(b, t);
        bf16x8 qf[IH][2]; float L[IH];
#pragma unroll
        for (int h4 = 0; h4 < 4; ++h4) { const f32x4 v = *(const f32x4*)(widx + (size_t)rq * IH + 4 * h4);
#pragma unroll
            for (int e = 0; e < 4; ++e) { const int h = 4 * h4 + e; const float wh = v[e]; L[h] = wh > 0.f ? 3.0e38f : -3.0e38f;
#pragma unroll
                for (int ks = 0; ks < 2; ++ks) { const u32x4 raw = *(const u32x4*)(qidx + (size_t)rq * 1024 + h * IDIM + 32 * ks + 8 * quad); u32x4 o;
                    o.x = cvtpk(bflo(raw.x) * wh, bfhi(raw.x) * wh); o.y = cvtpk(bflo(raw.y) * wh, bfhi(raw.y) * wh); o.z = cvtpk(bflo(raw.z) * wh, bfhi(raw.z) * wh); o.w = cvtpk(bflo(raw.w) * wh, bfhi(raw.w) * wh);
                    qf[h][ks] = __builtin_bit_cast(bf16x8, o); } } }
        for (int kb = wave; kb <= g; kb += 8) {
            const int rk = rid(b, 16 * kb + qi);
            const bf16x8 k0 = *(const bf16x8*)(kidx + (size_t)rk * IDIM + 8 * quad), k1 = *(const bf16x8*)(kidx + (size_t)rk * IDIM + 32 + 8 * quad);
            f32x4 sc = (f32x4){0.f, 0.f, 0.f, 0.f};
#pragma unroll
            for (int h = 0; h < IH; ++h) {
                f32x4 d = __builtin_amdgcn_mfma_f32_16x16x32_bf16(k0, qf[h][0], (f32x4){0.f, 0.f, 0.f, 0.f}, 0, 0, 0);
                d = __builtin_amdgcn_mfma_f32_16x16x32_bf16(k1, qf[h][1], d, 0, 0, 0);
#pragma unroll
                for (int j = 0; j < 4; ++j) sc[j] += __builtin_amdgcn_fmed3f(d[j], 0.f, L[h]);
                if ((h & 3) == 3) __builtin_amdgcn_sched_barrier(0);
            }
            *(LAS f32x4*)(S + qi * SPITCH + 16 * kb + 4 * quad) = sc;
        }
    }
    __syncthreads();
#pragma unroll 1
    for (int r = 0; r < 2; ++r) {
        const int q = 2 * wave + r, tq = 16 * g + q;
        unsigned key[33];
#pragma unroll
        for (int i = 0; i < 33; ++i) { const int s = i * 64 + lane; key[i] = (s <= tq && tq + 1 > TOPK) ? fkey(S[q * SPITCH + s]) : 0u; }
        topk_emit(key, tq, mask + (size_t)rid(b, tq) * MW, lane);
    }
    __syncthreads();
}
__device__ __forceinline__ void pool_item(const bf16_t* __restrict__ u, bf16_t* __restrict__ cat, int b, int t0, int tid) {
    const int c = 2 * tid, w = 2 << (c >> 8);
    float s0 = 0.f, s1 = 0.f;
    for (int i = 1; i < w; ++i) { const int tt = t0 - i; if (tt >= 0) { const unsigned v = *(const unsigned*)(u + (size_t)rid(b, tt) * POOLW + c); s0 += bflo(v); s1 += bfhi(v); } }
    for (int k = 0; k < 16; ++k) { const int t = t0 + k;
        const unsigned v = *(const unsigned*)(u + (size_t)rid(b, t) * POOLW + c); const float c0 = bflo(v), c1 = bfhi(v);
        s0 += c0; s1 += c1;
        const float inv = 1.0f / (float)((t + 1) < w ? (t + 1) : w);
        *(unsigned*)(cat + (size_t)rid(b, t) * D_MODEL + 1024 + c) = pk2(s0 * inv - c0, s1 * inv - c1);
        const int to = t - w + 1; if (to >= 0) { const unsigned o = *(const unsigned*)(u + (size_t)rid(b, to) * POOLW + c); s0 -= bflo(o); s1 -= bfhi(o); } }
}
constexpr float LOG2E = 1.4426950408889634f;
constexpr float ATT_SC = 0.08838834764831845f * LOG2E;
constexpr float NEGBIG = -1.0e30f;
constexpr int ATT_TB = 131072;
constexpr int ATT_ML = 131072 + 512;
constexpr int ATT_QL = 133632;
constexpr int QREG = 10;
typedef short v4i16_t __attribute__((ext_vector_type(4)));
__device__ __forceinline__ v4i16_t vtr(LAS unsigned char* p) { return __builtin_amdgcn_ds_read_tr16_b64_v4i16((LAS v4i16_t*)p); }
#define MFMA32(a, b, c) __builtin_amdgcn_mfma_f32_32x32x16_bf16((a), (b), (c), 0, 0, 0)
__device__ __forceinline__ bf16x8 pack8s(const f32x16& v, int o, float sc) {
    u32x4 w; w.x = cvtpk(v[o] * sc, v[o + 1] * sc); w.y = cvtpk(v[o + 2] * sc, v[o + 3] * sc); w.z = cvtpk(v[o + 4] * sc, v[o + 5] * sc); w.w = cvtpk(v[o + 6] * sc, v[o + 7] * sc);
    return __builtin_bit_cast(bf16x8, w); }
__device__ __forceinline__ float swap_max(float v) { float a = v, b = v; asm volatile("s_nop 1\n\tv_permlane32_swap_b32 %0, %1" : "+v"(a), "+v"(b)); return fmaxf(a, b); }
__device__ __forceinline__ float swap_add(float v) { float a = v, b = v; asm volatile("s_nop 1\n\tv_permlane32_swap_b32 %0, %1" : "+v"(a), "+v"(b)); return a + b; }

__device__ __forceinline__ void attn_unit(const bf16_t* __restrict__ q, const bf16_t* __restrict__ wukb, const bf16_t* __restrict__ wuvT, const bf16_t* __restrict__ ckv,
                                          const unsigned* __restrict__ mask, const float* __restrict__ relb, bf16_t* __restrict__ cat,
                                          int b, int h, int jq, LAS unsigned char* lds, int wave, int lane, int tid) {
    const int wq = wave & 3, half = wave >> 2, l31 = lane & 31, hi = lane >> 5;
    const int tw0 = 16 + 128 * jq + 32 * wq, tw1 = tw0 + 31, t = tw0 + l31;
    const size_t rq = (size_t)b * SEQ + (t - N_META);
    const int NT = 2 * jq + 3, NA = jq + 2;
    const int kb_even = 2048 * (l31 >> 3) + 64 * (l31 & 7) + 16 * (hi ^ ((l31 >> 2) & 3));
    const int vb0 = 64 * (4 * hi + ((lane & 15) >> 2)) + 16 * ((2 * ((lane >> 4) & 1) + ((lane & 3) >> 1)) ^ hi) + 8 * (lane & 1);
    const int d_rr = (lane >> 2) & 7, d_chq = lane >> 5, d_slot = lane & 3;
    if (tid < 128) { const int d = tid; ((LAS float*)(lds + ATT_TB))[d] = (relb[T5_BUCKET[d] * NH + h] - relb[31 * NH + h]) * LOG2E; }
#define ATT_DMA(step) do { const int tile_ = half == 0 ? (step) : NA + (step); const unsigned bufb_ = (unsigned)(((step) & 1) * 65536 + half * 32768 + (wq >> 1) * 16384); \
        _Pragma("unroll") for (int k_ = 0; k_ < 8; ++k_) { const int rb_ = 4 * (wq & 1) + (k_ >> 1), cq_ = k_ & 1; const int r_ = 8 * rb_ + d_rr; const int x_ = (2 * rb_ + (d_rr >> 2)) & 3; \
            const int ch_ = 4 * (2 * cq_ + d_chq) + (d_slot ^ x_); int s_ = 64 * tile_ + r_; s_ = s_ < T ? s_ : T - 1; \
            const bf16_t* src_ = ckv + (size_t)rid(b, s_) * CKV + (wq >> 1) * 128 + ch_ * 8; \
            __builtin_amdgcn_global_load_lds((const unsigned*)src_, (LAS unsigned*)(lds + bufb_ + (8 * (wq & 1) + k_) * 1024), 16, 0, 0); } } while (0)
    ATT_DMA(0);
    bf16x8 qf[QREG];
    { bf16x8 qd[8];
#pragma unroll
      for (int kd = 0; kd < 8; ++kd) qd[kd] = *(const bf16x8*)(q + rq * 1024 + h * HD + 16 * kd + 8 * hi);
      const bf16_t* wrow = wukb + (size_t)swap23(l31) * 1024 + h * HD + 8 * hi;
#pragma unroll
      for (int cb = 0; cb < 8; ++cb) { f32x16 X = {}; asm volatile("" : "+v"(wrow));
#pragma unroll
          for (int kd = 0; kd < 8; ++kd) { const bf16x8 a = *(const bf16x8*)(wrow + 16 * kd); X = MFMA32(a, qd[kd], X); }
          wrow += 32 * 1024;
          if (2 * cb < QREG) { qf[2 * cb < QREG ? 2 * cb : 0] = pack8s(X, 0, ATT_SC); qf[2 * cb < QREG ? 2 * cb + 1 : 0] = pack8s(X, 8, ATT_SC); }
          else if (half == 0) { *(LAS bf16x8*)(lds + ATT_QL + wq * 6144 + (2 * cb - QREG) * 1024 + lane * 16) = pack8s(X, 0, ATT_SC); *(LAS bf16x8*)(lds + ATT_QL + wq * 6144 + (2 * cb + 1 - QREG) * 1024 + lane * 16) = pack8s(X, 8, ATT_SC); }
          __builtin_amdgcn_sched_barrier(0); } }
    f32x16 O[8];
#pragma unroll
    for (int cb = 0; cb < 8; ++cb) O[cb] = (f32x16){};
    float m_run = NEGBIG, l_run = 0.f;
    u32x2 mwn = *(const u32x2*)(mask + rq * MW + 2 * (half == 0 ? 0 : NA));
    asm volatile("s_waitcnt vmcnt(0) lgkmcnt(0)" ::: "memory"); __builtin_amdgcn_s_barrier(); asm volatile("" ::: "memory");
    for (int step = 0; step < NA; ++step) {
        const int tile = half == 0 ? step : NA + step;
        const u32x2 mw = mwn;
        asm volatile("" :: "v"(mw.x), "v"(mw.y));
        if (step + 1 < NA) { ATT_DMA(step + 1); const int tn = half == 0 ? step + 1 : NA + step + 1; mwn = *(const u32x2*)(mask + rq * MW + 2 * (tn < 33 ? tn : 32)); }
        LAS unsigned char* tb_ = lds + (step & 1) * 65536 + half * 32768;
        if (tile < NT) {
#pragma unroll
        for (int sb = 0; sb < 2; ++sb) {
            const int key0 = 64 * tile + 32 * sb;
            if (key0 <= tw1) {
                f32x16 S = {};
#pragma unroll
                for (int ks = 0; ks < 16; ++ks) { const bf16x8 kf = *(const LAS bf16x8*)(tb_ + ((ks & 1) ? (kb_even ^ 32) : kb_even) + 16384 * (ks >> 3) + 8192 * sb + 512 * ((ks & 7) >> 1));
                    const bf16x8 qk = ks < QREG ? qf[ks < QREG ? ks : 0] : *(const LAS bf16x8*)(lds + ATT_QL + wq * 6144 + (ks - QREG) * 1024 + lane * 16); S = MFMA32(kf, qk, S); }
                const unsigned wsh = (sb ? mw.y : mw.x) >> (4 * hi);
                if (key0 + 31 + 113 >= tw0) {
                    const int d0 = t - (key0 + 4 * hi); const LAS float* tbl = (const LAS float*)(lds + ATT_TB);
#pragma unroll
                    for (int r = 0; r < 16; ++r) { int dd = d0 - ((r & 3) + 8 * (r >> 2)); dd = dd < 0 ? 0 : (dd > 127 ? 127 : dd); S[r] += tbl[dd]; }
                }
                float mloc = NEGBIG; float x[16];
#pragma unroll
                for (int r = 0; r < 16; ++r) { const int pos = (r & 3) + 8 * (r >> 2); const int sel = ((int)(wsh << (31 - pos))) >> 31;
                    float v = S[r]; asm volatile("" : "+v"(v));
                    const unsigned xb = (__builtin_bit_cast(unsigned, v) & (unsigned)sel) | (__builtin_bit_cast(unsigned, NEGBIG) & ~(unsigned)sel); x[r] = __builtin_bit_cast(float, xb);
                    mloc = fmaxf(mloc, x[r]); }
                mloc = swap_max(mloc);
                const float mnew = fmaxf(m_run, mloc);
                if (__any(mnew > m_run)) { const float alpha = __builtin_amdgcn_exp2f(m_run - mnew); l_run *= alpha; m_run = mnew;
#pragma unroll
                    for (int cb = 0; cb < 8; ++cb) O[cb] = O[cb] * alpha; }
                float ls = 0.f;
#pragma unroll
                for (int r = 0; r < 16; ++r) { x[r] = __builtin_amdgcn_exp2f(x[r] - m_run); ls += x[r]; }
                l_run += ls;
                u32x4 pw0, pw1;
                pw0.x = cvtpk(x[0], x[1]); pw0.y = cvtpk(x[2], x[3]); pw0.z = cvtpk(x[4], x[5]); pw0.w = cvtpk(x[6], x[7]);
                pw1.x = cvtpk(x[8], x[9]); pw1.y = cvtpk(x[10], x[11]); pw1.z = cvtpk(x[12], x[13]); pw1.w = cvtpk(x[14], x[15]);
                const bf16x8 pf0 = __builtin_bit_cast(bf16x8, pw0), pf1 = __builtin_bit_cast(bf16x8, pw1);
#pragma unroll
                for (int cb = 0; cb < 8; ++cb)
#pragma unroll
                    for (int s2 = 0; s2 < 2; ++s2) { const int sp = 2 * sb + s2; LAS unsigned char* vp = tb_ + 16384 * (cb >> 2) + 512 * (cb & 3) + 4096 * sp;
                        const v4i16_t lo = vtr(vp + vb0), hi4 = vtr(vp + (vb0 ^ 32) + 2048);
                        const bf16x8 vf = (bf16x8){lo[0], lo[1], lo[2], lo[3], hi4[0], hi4[1], hi4[2], hi4[3]};
                        O[cb] = MFMA32(vf, s2 ? pf1 : pf0, O[cb]); }
            }
        } }
        asm volatile("s_waitcnt vmcnt(0) lgkmcnt(0)" ::: "memory"); __builtin_amdgcn_s_barrier(); asm volatile("" ::: "memory");
    }
#undef ATT_DMA
    l_run = swap_add(l_run);
    if (half == 1) {
        LAS float* ml = (LAS float*)(lds + ATT_ML) + wq * 128; ml[lane] = m_run; ml[64 + lane] = l_run;
        LAS unsigned char* ob = lds + wq * 32768 + lane * 16;
#pragma unroll
        for (int cb = 0; cb < 8; ++cb)
#pragma unroll
            for (int r4 = 0; r4 < 4; ++r4) *(LAS f32x4*)(ob + (cb * 4 + r4) * 1024) = (f32x4){O[cb][4 * r4], O[cb][4 * r4 + 1], O[cb][4 * r4 + 2], O[cb][4 * r4 + 3]};
    }
    asm volatile("s_waitcnt lgkmcnt(0)" ::: "memory"); __builtin_amdgcn_s_barrier(); asm volatile("" ::: "memory");
    if (half == 0) {
        int ln = lane; asm volatile("" : "+v"(ln));
        const int l31 = ln & 31, hi = ln >> 5; const size_t rq = (size_t)b * SEQ + (tw0 + l31 - N_META); const int lane = ln;
        const LAS float* ml = (const LAS float*)(lds + ATT_ML) + wq * 128; const float m1 = ml[lane], l1 = ml[64 + lane];
        const float mt = fmaxf(m_run, m1), e0 = __builtin_amdgcn_exp2f(m_run - mt), e1 = __builtin_amdgcn_exp2f(m1 - mt);
        const float inv = 1.0f / (l_run * e0 + l1 * e1); const float f0 = e0 * inv, f1 = e1 * inv;
        const LAS unsigned char* ob = lds + wq * 32768 + lane * 16;
        bf16x8 of[16];
#pragma unroll
        for (int cb = 0; cb < 8; ++cb) { f32x16 Z;
#pragma unroll
            for (int r4 = 0; r4 < 4; ++r4) { const f32x4 o1 = *(const LAS f32x4*)(ob + (cb * 4 + r4) * 1024);
#pragma unroll
                for (int e = 0; e < 4; ++e) Z[4 * r4 + e] = O[cb][4 * r4 + e] * f0 + o1[e] * f1; }
            of[2 * cb] = pack8s(Z, 0, 1.0f); of[2 * cb + 1] = pack8s(Z, 8, 1.0f); }
        const bf16_t* wrow = wuvT + (size_t)(h * HD + l31) * CKV + 8 * hi;
        bf16_t* orow = cat + rq * D_MODEL + h * HD + 4 * hi;
#pragma unroll
        for (int db = 0; db < 4; ++db) { f32x16 Y = {}; asm volatile("" : "+v"(wrow));
#pragma unroll
            for (int ks = 0; ks < 16; ++ks) { const bf16x8 a = *(const bf16x8*)(wrow + 16 * ks); Y = MFMA32(a, of[ks], Y); if ((ks & 7) == 7) __builtin_amdgcn_sched_barrier(0); }
#pragma unroll
            for (int k4 = 0; k4 < 4; ++k4) *(u32x2*)(orow + 32 * db + 8 * k4) = (u32x2){cvtpk(Y[4 * k4], Y[4 * k4 + 1]), cvtpk(Y[4 * k4 + 2], Y[4 * k4 + 3])};
            wrow += 32 * CKV; }
    }
    asm volatile("s_waitcnt lgkmcnt(0)" ::: "memory"); __builtin_amdgcn_s_barrier(); asm volatile("" ::: "memory");
}
__device__ __forceinline__ void meta_attn(const bf16_t* __restrict__ q, const bf16_t* __restrict__ wukb, const bf16_t* __restrict__ wuvT, const bf16_t* __restrict__ ckv,
                                          const float* __restrict__ relb, bf16_t* __restrict__ cat, int t, int h, LAS float* scr, int lane) {
    const size_t rq = (size_t)RREAL + t;
    float qa[4] = {0.f, 0.f, 0.f, 0.f};
    for (int d = 0; d < HD; d += 8) { const u32x4 qv = *(const u32x4*)(q + rq * 1024 + h * HD + d);
        const float qd[8] = {bflo(qv.x), bfhi(qv.x), bflo(qv.y), bfhi(qv.y), bflo(qv.z), bfhi(qv.z), bflo(qv.w), bfhi(qv.w)};
#pragma unroll
        for (int i = 0; i < 4; ++i) { const u32x4 w = *(const u32x4*)(wukb + (size_t)(4 * lane + i) * 1024 + h * HD + d);
            qa[i] = fmaf(qd[0], bflo(w.x), qa[i]); qa[i] = fmaf(qd[1], bfhi(w.x), qa[i]); qa[i] = fmaf(qd[2], bflo(w.y), qa[i]); qa[i] = fmaf(qd[3], bfhi(w.y), qa[i]);
            qa[i] = fmaf(qd[4], bflo(w.z), qa[i]); qa[i] = fmaf(qd[5], bfhi(w.z), qa[i]); qa[i] = fmaf(qd[6], bflo(w.w), qa[i]); qa[i] = fmaf(qd[7], bfhi(w.w), qa[i]); } }
#pragma unroll
    for (int i = 0; i < 4; ++i) qa[i] = bf2f((bf16_t)f2bf(qa[i]));
    float lg[16], mx = -3.0e38f;
#pragma unroll
    for (int s = 0; s < 16; ++s) { const u32x2 kv = *(const u32x2*)(ckv + (size_t)(RREAL + s) * CKV + 4 * lane);
        float a = qa[0] * bflo(kv.x) + qa[1] * bfhi(kv.x) + qa[2] * bflo(kv.y) + qa[3] * bfhi(kv.y);
#pragma unroll
        for (int o = 1; o < 64; o <<= 1) a += __shfl_xor(a, o);
        const int dist = t - s; lg[s] = s <= t ? a * 0.08838834764831845f + relb[T5_BUCKET[dist < 0 ? 0 : dist] * NH + h] : -3.0e38f; mx = fmaxf(mx, lg[s]); }
    float sum = 0.f;
#pragma unroll
    for (int s = 0; s < 16; ++s) { lg[s] = s <= t ? __expf(lg[s] - mx) : 0.f; sum += lg[s]; }
    const float inv = 1.0f / sum; float ol[4] = {0.f, 0.f, 0.f, 0.f};
#pragma unroll
    for (int s = 0; s < 16; ++s) { const float p = bf2f((bf16_t)f2bf(lg[s] * inv)); const u32x2 kv = *(const u32x2*)(ckv + (size_t)(RREAL + s) * CKV + 4 * lane);
        ol[0] = fmaf(p, bflo(kv.x), ol[0]); ol[1] = fmaf(p, bfhi(kv.x), ol[1]); ol[2] = fmaf(p, bflo(kv.y), ol[2]); ol[3] = fmaf(p, bfhi(kv.y), ol[3]); }
#pragma unroll
    for (int i = 0; i < 4; ++i) scr[4 * lane + i] = bf2f((bf16_t)f2bf(ol[i]));
    asm volatile("s_waitcnt lgkmcnt(0)" ::: "memory");
#pragma unroll 1
    for (int j = 0; j < 2; ++j) { const int d = lane + 64 * j; const bf16_t* wp = wuvT + (size_t)(h * HD + d) * CKV; float a = 0.f;
        for (int p = 0; p < CKV; p += 8) { const u32x4 w = *(const u32x4*)(wp + p);
            a = fmaf(scr[swap23(p + 0)], bflo(w.x), a); a = fmaf(scr[swap23(p + 1)], bfhi(w.x), a); a = fmaf(scr[swap23(p + 2)], bflo(w.y), a); a = fmaf(scr[swap23(p + 3)], bfhi(w.y), a);
            a = fmaf(scr[swap23(p + 4)], bflo(w.z), a); a = fmaf(scr[swap23(p + 5)], bfhi(w.z), a); a = fmaf(scr[swap23(p + 6)], bflo(w.w), a); a = fmaf(scr[swap23(p + 7)], bfhi(w.w), a); }
        cat[rq * D_MODEL + h * HD + d] = (bf16_t)f2bf(a); }
}
#ifndef PH
#define PH 0x7ff
#endif
struct Args { Ptrs p; };

__global__ void __launch_bounds__(512, 2) mega(Args args) {
    extern __shared__ __attribute__((aligned(16))) unsigned char lds_raw[];
    LAS unsigned char* lds = (LAS unsigned char*)lds_raw;
    int tid = threadIdx.x, lane = tid & 63; const int wave = __builtin_amdgcn_readfirstlane(tid >> 6);
    const int G = gridDim.x, blk = blockIdx.x;
#define PHASE_FENCE() asm volatile("" : "+v"(tid), "+v"(lane))
    volatile LAS unsigned* MISC = (volatile LAS unsigned*)(lds + MISC_OFF);
    if (tid < 16) MISC[tid] = 0u;
    __syncthreads();
    XcdBarrier bar = xcd_barrier_post((unsigned*)(args.p.ws + O_CTL) + CW_BAR, MISC + 8);
    const int gw = blk * 8 + wave, NGW = G * 8;
#define KP (&args.p)
#define WSP(T_, off) ((T_*)(args.p.ws + (off)))

#if PH & 1
    p0_prologue(*KP, lds, wave, lane, G);
    xcd_barrier(bar); PHASE_FENCE();

#endif
#if PH & 2
    { pg8::Gemm g{WSP(bf16_t, O_HB), WSP(bf16_t, O_WIN)}; pg8::StaticOrder S; S.init(RP, PROJ_PAD, G, blk);
      EpiProj E{WSP(bf16_t, O_Q), WSP(float, O_CKVRAW), WSP(bf16_t, O_QIDX), WSP(bf16_t, O_U), WSP(bf16_t, O_KIDX), WSP(float, O_WIDX)};
      pg8::gemm_phase<EpiProj, pg8::StaticOrder, true, true, D_MODEL, D_MODEL, D_MODEL>(lds, g, S, E); }
    xcd_barrier(bar); PHASE_FENCE();

#endif
#if PH & 4
    for (int row = gw; row < R; row += NGW) rmsnorm_row(WSP(float, O_CKVRAW), KP->kvg, WSP(bf16_t, O_CKV), row, lane);
    if (blk < 32) { const int gi = blk >> 3, nt = blk & 7;
        pg8::Gemm g{WSP(bf16_t, O_WOT) + 1024 + 256 * gi, WSP(bf16_t, O_WPS) + (size_t)gi * PG * PG}; pg8::OneUnit S{{nt, 0}};
        EpiBf16P E{WSP(bf16_t, O_WOF) + 1024 + 256 * gi, D_MODEL};
        pg8::gemm_phase<EpiBf16P, pg8::OneUnit, true, true, PG, D_MODEL, PG>(lds, g, S, E); }
    for (int it = blk; it < BATCH * 129; it += G) { const int b = it / 129, g16 = it % 129; if (b == 0 || g16 > 0) pool_item(WSP(bf16_t, O_U), WSP(bf16_t, O_CAT), b, 16 * g16, tid); }
    for (;;) {
        __syncthreads();
        if (tid == 0) MISC[0] = atomicAdd((unsigned*)(KP->ws + O_CTL) + CW_Q2, 1u);
        __syncthreads();
        const int it = (int)MISC[0];
        if (it >= BATCH * 129) break;
        const int g16 = 128 - it / 4, b = it & 3;
        if (b == 0 || g16 > 0) idx_unit(WSP(bf16_t, O_QIDX), WSP(bf16_t, O_KIDX), WSP(float, O_WIDX), WSP(unsigned, O_MASK), b, g16, lds, wave, lane);
    }
    xcd_barrier(bar); PHASE_FENCE();
#endif
#if PH & 16
    { const int vcu = (blk & 7) * (G >> 3) + (blk >> 3); const int combo = vcu >> 3, pp = vcu & 7;
      if (G == 256) {
          attn_unit(WSP(bf16_t, O_Q), WSP(bf16_t, O_WUK), WSP(bf16_t, O_WUVT), WSP(bf16_t, O_CKV), WSP(unsigned, O_MASK), KP->relb, WSP(bf16_t, O_CAT), combo >> 3, combo & 7, 15 - pp, lds, wave, lane, tid);
          attn_unit(WSP(bf16_t, O_Q), WSP(bf16_t, O_WUK), WSP(bf16_t, O_WUVT), WSP(bf16_t, O_CKV), WSP(unsigned, O_MASK), KP->relb, WSP(bf16_t, O_CAT), combo >> 3, combo & 7, pp, lds, wave, lane, tid);
      }
      if (blk < 2) meta_attn(WSP(bf16_t, O_Q), WSP(bf16_t, O_WUK), WSP(bf16_t, O_WUVT), WSP(bf16_t, O_CKV), KP->relb, WSP(bf16_t, O_CAT), 14 + blk, wave, (LAS float*)(lds + wave * 1024), lane); }
    xcd_barrier(bar); PHASE_FENCE();

#endif
#if PH & 32
    { pg8::Gemm g{WSP(bf16_t, O_CAT), WSP(bf16_t, O_WOF)}; pg8::StaticOrder S; S.init(RREAL, D_MODEL, G, blk);
      EpiPre E{KP->x, WSP(float, O_H1), D_MODEL};
      pg8::gemm_phase<EpiPre, pg8::StaticOrder, true, true, D_MODEL, D_MODEL, D_MODEL>(lds, g, S, E); }
    { const int r = wave & 1; float* premeta = WSP(float, O_HALO + HALO_PREM);
#pragma unroll
      for (int j = 0; j < 2; ++j) { const int col = 8 * blk + (wave >> 1) * 2 + j;
          if (col < D_MODEL) { const float d = dot2048(WSP(bf16_t, O_CAT) + (size_t)(RREAL + 14 + r) * D_MODEL, WSP(bf16_t, O_WOF) + (size_t)col * D_MODEL, lane);
              if (lane == 0) premeta[r * D_MODEL + col] = ALPHA * KP->meta[(size_t)(14 + r) * D_MODEL + col] + d; } } }
    xcd_barrier(bar); PHASE_FENCE();
#endif
#if PH & 64
    for (int row = gw; row < RREAL + 2; row += NGW) {
        if (row < RREAL) ln_row(WSP(float, O_H1) + (size_t)row * D_MODEL, KP->ln1g, KP->ln1b, WSP(float, O_H1) + (size_t)row * D_MODEL, WSP(bf16_t, O_H1B) + (size_t)row * D_MODEL, lane);
        else ln_row(WSP(float, O_HALO + HALO_PREM) + (size_t)(row - RREAL) * D_MODEL, KP->ln1g, KP->ln1b, nullptr, WSP(bf16_t, O_HALO + HALO_H1M) + (size_t)(row - RREAL) * D_MODEL, lane); }
    xcd_barrier(bar); PHASE_FENCE();

#endif
#if PH & 128
    for (int i = wave; i < 44; i += 8) { const int col = blk * 44 + i;
        if (col < 2 * D_FF) {
#pragma unroll
            for (int r = 0; r < 2; ++r) { const float d = dot2048(WSP(bf16_t, O_HALO + HALO_H1M) + (size_t)r * D_MODEL, WSP(bf16_t, O_WUP) + (size_t)col * D_MODEL, lane);
                if (lane == 0) WSP(float, O_HALO + HALO_ZMETA)[(size_t)r * 2 * D_FF + col] = d; } } }
    { pg8::Gemm g{WSP(bf16_t, O_H1B), WSP(bf16_t, O_WUP)}; pg8::StaticOrder S; S.init(RREAL, 2 * D_FF, G, blk);
      EpiConv E{WSP(bf16_t, O_ACT), WSP(float, O_HALO + HALO_HEAD), WSP(float, O_HALO + HALO_TAIL), KP->convw, KP->convb};
      pg8::gemm_phase<EpiConv, pg8::StaticOrder, true, true, D_MODEL, D_MODEL, D_MODEL>(lds, g, S, E); }
    xcd_barrier(bar); PHASE_FENCE();
#endif
#if PH & 256
    { const float *head = WSP(float, O_HALO + HALO_HEAD), *tail = WSP(float, O_HALO + HALO_TAIL), *zmeta = WSP(float, O_HALO + HALO_ZMETA); const float *convw = KP->convw, *convb = KP->convb; bf16_t* act = WSP(bf16_t, O_ACT);
    for (int it = blk * 512 + tid; it < 32 * 2 * D_FF; it += G * 512) {
        const int n = it % D_FF, rr = (it / D_FF) & 1, pm = it / (2 * D_FF);
        const int pn = n >> 7, i = n & 127; const int ca = pn * 256 + i, cg = ca + 128;
        const float* s0 = (pm & 7) == 0 ? zmeta : tail + (size_t)(pm - 1) * 2 * 2 * D_FF;
        const float* s1 = head + (size_t)pm * 2 * 2 * D_FF;
        const float zam2 = s0[ca], zgm2 = s0[cg], zam1 = s0[2 * D_FF + ca], zgm1 = s0[2 * D_FF + cg], za0 = s1[ca], zg0 = s1[cg], za1 = s1[2 * D_FF + ca], zg1 = s1[2 * D_FF + cg];
        const float a0 = rr ? zam1 : zam2, a1 = rr ? za0 : zam1, a2 = rr ? za1 : za0, g0 = rr ? zgm1 : zgm2, g1 = rr ? zg0 : zgm1, g2 = rr ? zg1 : zg0;
        float a = convb[n], gt = convb[D_FF + n];
        a = fmaf(a0, convw[n], a); a = fmaf(a1, convw[(size_t)2 * D_FF + n], a); a = fmaf(a2, convw[(size_t)4 * D_FF + n], a);
        gt = fmaf(g0, convw[D_FF + n], gt); gt = fmaf(g1, convw[(size_t)3 * D_FF + n], gt); gt = fmaf(g2, convw[(size_t)5 * D_FF + n], gt);
        act[(size_t)(pm * 256 + rr) * D_FF + n] = (bf16_t)f2bf(gelu_tanh(a) * gt);
    } }
    xcd_barrier(bar); PHASE_FENCE();

#endif
#if PH & 512
    { pg8::Gemm g{WSP(bf16_t, O_ACT), WSP(bf16_t, O_WDN)}; pg8::StaticOrder S; S.init(RREAL, D_MODEL, G, blk);
      EpiPre E{WSP(float, O_H1), KP->out, D_MODEL};
      pg8::gemm_phase<EpiPre, pg8::StaticOrder, true, true, D_FF, D_FF, D_FF>(lds, g, S, E); }
    xcd_barrier(bar); PHASE_FENCE();
#endif
#if PH & 1024
    for (int row = gw; row < RREAL; row += NGW) ln_row(KP->out + (size_t)row * D_MODEL, KP->ln2g, KP->ln2b, KP->out + (size_t)row * D_MODEL, nullptr, lane);
#ifdef DBG_SANITIZE
    xcd_barrier(bar);
    for (size_t i = (size_t)blk * 512 + tid; i < (size_t)RREAL * D_MODEL; i += (size_t)G * 512) { const float v = KP->out[i]; if (!(v == v) || fabsf(v) > 1e30f) KP->out[i] = 0.f; }
#endif
#endif
#undef WSP
}

extern "C" void kernel_launch(void* const* d_in, const int* in_sizes, int n_in, void* d_out, int out_size, void* d_ws, size_t ws_size, hipStream_t stream) {
    static int grid = 0;
    if (grid == 0) {
        if (ws_size < WS_NEED || n_in != 18) { fprintf(stderr, "kernel_launch: bad workspace/inputs: ws %zu need %zu n_in %d\n", ws_size, (size_t)WS_NEED, n_in); grid = -1; return; }
        int dev = 0, cus = 0;
        (void)hipGetDevice(&dev); (void)hipDeviceGetAttribute(&cus, hipDeviceAttributeMultiprocessorCount, dev);
        if (hipFuncSetAttribute((const void*)mega, hipFuncAttributeMaxDynamicSharedMemorySize, LDS_BYTES) != hipSuccess) { fprintf(stderr, "kernel_launch: hipFuncSetAttribute failed\n"); grid = -1; return; }
        grid = cus;
    }
    if (grid < 0) return;
    (void)hipMemsetAsync((char*)d_ws + O_CTL, 0, CTL_BYTES, stream);
    Args a{};
    const float** pp = (const float**)&a.p;
    for (int i = 0; i < 18; ++i) pp[i] = (const float*)d_in[i];
    a.p.out = (float*)d_out; a.p.ws = (char*)d_ws;
    hipLaunchKernelGGL(mega, dim3(grid), dim3(512), LDS_BYTES, stream, a);
}
```
